# Optimizing an MI355X kernel written in HIP

```python
import jax, jax.numpy as jnp
from jax import lax
import numpy as np

D_MODEL = 1024
BATCH = 8
SEQ = 2048
DEPTH = 2
DEC_BATCH = 8
DEC_SEQ = 64
PAST_LEN = 2048

CHUNK = 64
N_MIXERS = 2
N_CONV_LAYERS = (DEPTH + N_MIXERS - 1) // N_MIXERS
N_ATTN_LAYERS = DEPTH // N_MIXERS
CONV_WIDTH = 3
N_HEADS = 16
HEAD_DIM = D_MODEL // N_HEADS
D_FF = 2816
Q_BLOCK = 128
FFN_RESIDUAL = 0.5
NORM_EPS = 1e-6
FORGET_BIAS_MEAN = 3.0
NEG_INF = -1e30

kernel_name = "conv_fox_macaron_stream_step"


def rms_norm(x, g):
    xf = x.astype(jnp.float32)
    y = xf * lax.rsqrt(jnp.mean(xf * xf, axis=-1, keepdims=True) + NORM_EPS)
    return (y * g.astype(jnp.float32)).astype(x.dtype)


def swiglu_ffn(x, g, w_in, w_out):
    a, b = jnp.split(rms_norm(x, g) @ w_in, 2, axis=-1)
    return (jax.nn.silu(a) * b) @ w_out


def conv_mixer(xn, hist, w_in, w_k, w_out):
    gate_b, gate_c, h = jnp.split(xn @ w_in, 3, axis=-1)
    u = gate_c * h
    u_full = jnp.concatenate([hist.astype(u.dtype), u], axis=1)
    t_len = u.shape[1]
    conv = w_k[0] * u_full[:, 0:t_len]
    for j in range(1, CONV_WIDTH):
        conv = conv + w_k[j] * u_full[:, j:j + t_len]
    y = (gate_b * conv) @ w_out
    return y, u_full[:, t_len:]


def fox_project(xn, w_in, b_f, gq, gk):
    b, t, _ = xn.shape
    proj = xn @ w_in
    q = proj[..., :D_MODEL].reshape(b, t, N_HEADS, HEAD_DIM)
    k = proj[..., D_MODEL:2 * D_MODEL].reshape(b, t, N_HEADS, HEAD_DIM)
    v = proj[..., 2 * D_MODEL:3 * D_MODEL].reshape(b, t, N_HEADS, HEAD_DIM)
    f_logit = proj[..., 3 * D_MODEL:].astype(jnp.float32) + b_f.astype(jnp.float32)
    q = rms_norm(q, gq)
    k = rms_norm(k, gk)
    logf = jax.nn.log_sigmoid(f_logit)
    return q, k, v, logf


def fox_attend(q, k, v, c_q, c_k, q_pos, k_pos):
    s = jnp.einsum('bqhd,bkhd->bhqk', q, k, preferred_element_type=jnp.float32) * (HEAD_DIM ** -0.5)
    decay = jnp.transpose(c_q, (0, 2, 1))[..., :, None] - jnp.transpose(c_k, (0, 2, 1))[..., None, :]
    mask = k_pos[None, :] <= q_pos[:, None]
    s = jnp.where(mask, s + decay, NEG_INF)
    p = jax.nn.softmax(s, axis=-1)
    return jnp.einsum('bhqk,bkhd->bqhd', p.astype(v.dtype), v)


def fox_prompt(q, k, v, logf):
    b, s_len, h, d = q.shape
    nb = s_len // Q_BLOCK
    c = jnp.cumsum(logf, axis=1)
    qb = jnp.transpose(q.reshape(b, nb, Q_BLOCK, h, d), (1, 0, 2, 3, 4))
    cb = jnp.transpose(c.reshape(b, nb, Q_BLOCK, h), (1, 0, 2, 3))
    k_pos = jnp.arange(s_len)

    def block(args):
        idx, q_blk, c_blk = args
        q_pos = idx * Q_BLOCK + jnp.arange(Q_BLOCK)
        return fox_attend(q_blk, k, v, c_blk, c, q_pos, k_pos)

    out = lax.map(block, (jnp.arange(nb), qb, cb))
    return jnp.transpose(out, (1, 0, 2, 3, 4)).reshape(b, s_len, h * d)


def fox_sample(q, k, v, logf, past_k, past_v, past_logf):
    b, t_len, h, d = q.shape
    past = past_k.shape[1]
    k_all = jnp.concatenate([past_k.astype(k.dtype), k], axis=1)
    v_all = jnp.concatenate([past_v.astype(v.dtype), v], axis=1)
    c_all = jnp.cumsum(jnp.concatenate([past_logf.astype(jnp.float32), logf], axis=1), axis=1)
    q_pos = past + jnp.arange(t_len)
    k_pos = jnp.arange(past + t_len)
    out = fox_attend(q, k_all, v_all, c_all[:, past:], c_all, q_pos, k_pos)
    return out.reshape(b, t_len, h * d)


def setup_inputs(seed: int = 0) -> dict:
    key = jax.random.key(seed)
    ks = jax.random.split(key, 18)
    nrm = lambda k, shape: jax.random.normal(k, shape, jnp.float32)
    D, H, F = D_MODEL, N_HEADS, D_FF
    return {
        "x_prompt": nrm(ks[0], (BATCH, SEQ, D)),
        "x_sample": nrm(ks[1], (DEC_BATCH, DEC_SEQ, D)),
        "state_conv": nrm(ks[2], (N_CONV_LAYERS, DEC_BATCH, CONV_WIDTH - 1, D)),
        "cache_k": nrm(ks[3], (N_ATTN_LAYERS, DEC_BATCH, PAST_LEN, H, HEAD_DIM)),
        "cache_v": nrm(ks[4], (N_ATTN_LAYERS, DEC_BATCH, PAST_LEN, H, HEAD_DIM)),
        "cache_logf": jax.nn.log_sigmoid(FORGET_BIAS_MEAN + 0.5 * nrm(ks[5], (N_ATTN_LAYERS, DEC_BATCH, PAST_LEN, H))),
        "norm_ffn": 1.0 + 0.05 * nrm(ks[6], (DEPTH, 2, D)),
        "ffn_w_in": nrm(ks[7], (DEPTH, 2, D, 2 * F)) * D ** -0.5,
        "ffn_w_out": nrm(ks[8], (DEPTH, 2, F, D)) * F ** -0.5,
        "norm_mix": 1.0 + 0.05 * nrm(ks[9], (DEPTH, D)),
        "conv_w_in": nrm(ks[10], (N_CONV_LAYERS, D, 3 * D)) * D ** -0.5,
        "conv_w": nrm(ks[11], (N_CONV_LAYERS, CONV_WIDTH, D)) * CONV_WIDTH ** -0.5,
        "conv_w_out": nrm(ks[12], (N_CONV_LAYERS, D, D)) * D ** -0.5,
        "attn_w_in": nrm(ks[13], (N_ATTN_LAYERS, D, 3 * D + H)) * D ** -0.5,
        "attn_b_f": FORGET_BIAS_MEAN + 0.5 * nrm(ks[14], (N_ATTN_LAYERS, H)),
        "q_norm": 1.0 + 0.05 * nrm(ks[15], (N_ATTN_LAYERS, HEAD_DIM)),
        "k_norm": 1.0 + 0.05 * nrm(ks[16], (N_ATTN_LAYERS, HEAD_DIM)),
        "attn_w_out": nrm(ks[17], (N_ATTN_LAYERS, D, D)) * D ** -0.5,
    }


def reference(x_prompt, x_sample, state_conv, cache_k, cache_v, cache_logf,
              norm_ffn, ffn_w_in, ffn_w_out, norm_mix,
              conv_w_in, conv_w, conv_w_out,
              attn_w_in, attn_b_f, q_norm, k_norm, attn_w_out):
    yp, ys = x_prompt, x_sample
    conv_p, conv_s = [], []
    kp_l, vp_l, fp_l, ks_l, vs_l, fs_l = [], [], [], [], [], []
    for i in range(DEPTH):
        li = i // N_MIXERS
        yp = yp + FFN_RESIDUAL * swiglu_ffn(yp, norm_ffn[i, 0], ffn_w_in[i, 0], ffn_w_out[i, 0])
        ys = ys + FFN_RESIDUAL * swiglu_ffn(ys, norm_ffn[i, 0], ffn_w_in[i, 0], ffn_w_out[i, 0])
        xn_p = rms_norm(yp, norm_mix[i])
        xn_s = rms_norm(ys, norm_mix[i])
        if i % N_MIXERS == 0:
            hist_p = jnp.zeros((yp.shape[0], CONV_WIDTH - 1, D_MODEL), yp.dtype)
            mp, st_p = conv_mixer(xn_p, hist_p, conv_w_in[li], conv_w[li], conv_w_out[li])
            ms, st_s = conv_mixer(xn_s, state_conv[li], conv_w_in[li], conv_w[li], conv_w_out[li])
            conv_p.append(st_p)
            conv_s.append(st_s)
        else:
            qp, kp, vp, fp = fox_project(xn_p, attn_w_in[li], attn_b_f[li], q_norm[li], k_norm[li])
            qs, kq, vq, fq = fox_project(xn_s, attn_w_in[li], attn_b_f[li], q_norm[li], k_norm[li])
            mp = fox_prompt(qp, kp, vp, fp) @ attn_w_out[li]
            ms = fox_sample(qs, kq, vq, fq, cache_k[li], cache_v[li], cache_logf[li]) @ attn_w_out[li]
            kp_l.append(kp); vp_l.append(vp); fp_l.append(fp)
            ks_l.append(kq); vs_l.append(vq); fs_l.append(fq)
        yp = yp + mp
        ys = ys + ms
        yp = yp + FFN_RESIDUAL * swiglu_ffn(yp, norm_ffn[i, 1], ffn_w_in[i, 1], ffn_w_out[i, 1])
        ys = ys + FFN_RESIDUAL * swiglu_ffn(ys, norm_ffn[i, 1], ffn_w_in[i, 1], ffn_w_out[i, 1])
    return (yp, ys,
            jnp.stack(conv_p), jnp.stack(conv_s),
            jnp.stack(kp_l), jnp.stack(vp_l), jnp.stack(fp_l),
            jnp.stack(ks_l), jnp.stack(vs_l), jnp.stack(fs_l))
```

```cpp
#include <hip/hip_runtime.h>
#include <hip/hip_bf16.h>
#include <cstdio>
#include <cstdint>
#include <cmath>

#ifndef MK_ONE_LAUNCH
#define MK_ONE_LAUNCH 1
#endif
#ifndef MK_FAST_GEMM
#define MK_FAST_GEMM 1
#endif
#ifndef MK_FAST_ATTN
#define MK_FAST_ATTN 0
#endif

constexpr int D = 1024, NH = 16, HD = 64, FF = 2816, SEQ = 2048, NB = 8, DSEQ = 64, PAST = 2048;
constexpr int MP = NB * SEQ, MS = NB * DSEQ, M = MP + MS;
constexpr int NAI = 3328;
constexpr float NORM_EPS = 1e-6f, LOG2E = 1.4426950408889634f;
constexpr float QSCALE = 0.125f * LOG2E;

constexpr size_t O_Y = 0;
constexpr size_t O_CSP = (size_t)M * D;
constexpr size_t O_CSS = O_CSP + (size_t)NB * 2 * D;
constexpr size_t O_KP = O_CSS + (size_t)NB * 2 * D;
constexpr size_t O_VP = O_KP + (size_t)MP * D;
constexpr size_t O_LFP = O_VP + (size_t)MP * D;
constexpr size_t O_KS = O_LFP + (size_t)MP * NH;
constexpr size_t O_VS = O_KS + (size_t)MS * D;
constexpr size_t O_LFS = O_VS + (size_t)MS * D;
constexpr size_t O_END = O_LFS + (size_t)MS * NH;

constexpr size_t MiB = 1u << 20;
constexpr size_t WS_CTL = 0, CTL_ZERO_BYTES = 1 * MiB;
constexpr size_t SZ_FFI = (size_t)2 * FF * D * 2, SZ_FFO = (size_t)D * FF * 2;
constexpr size_t WS_FFI = 1 * MiB;
constexpr size_t WS_FFO = WS_FFI + 4 * SZ_FFI;
constexpr size_t WS_CI = WS_FFO + 4 * SZ_FFO;
constexpr size_t WS_CO = WS_CI + (size_t)3 * D * D * 2;
constexpr size_t WS_AI = WS_CO + (size_t)D * D * 2;
constexpr size_t WS_AO = WS_AI + (size_t)NAI * D * 2;
constexpr size_t WS_XB = WS_AO + (size_t)D * D * 2;
constexpr size_t WS_RS = WS_XB + (size_t)M * D * 2;
constexpr size_t WS_BIG = ((WS_RS + (size_t)M * 16 + MiB - 1) / MiB) * MiB;
constexpr size_t SZ_ACT = (size_t)M * D * 2;
constexpr size_t WS_H = WS_BIG;
constexpr size_t WS_END = WS_BIG + 3 * SZ_ACT;
static_assert(WS_END <= 256 * MiB && (size_t)M * FF * 2 <= 3 * SZ_ACT, "d_ws map");
constexpr int CW_TMO = 0, CW_CODE = 1, CW_BAR = 4096;

constexpr int RING_OFF = 0, RING_BYTES = 131072, LDSCTL_OFF = RING_BYTES, MISC_OFF = LDSCTL_OFF + 320, LDS_BYTES = 147456;
constexpr int NWAVES = 8;
constexpr int NPH = 15;

#define GAS __attribute__((address_space(1)))
#define LAS __attribute__((address_space(3)))
typedef unsigned short bf16;
typedef unsigned v4u __attribute__((ext_vector_type(4)));
typedef unsigned v2u __attribute__((ext_vector_type(2)));
typedef GAS unsigned gu32;
#define RLX_AGENT __ATOMIC_RELAXED, __HIP_MEMORY_SCOPE_AGENT
#define LDS_WAIT() asm volatile("s_waitcnt lgkmcnt(0)" ::: "memory")
#define VM_WAIT() asm volatile("s_waitcnt vmcnt(0)" ::: "memory")
__device__ __forceinline__ unsigned f2bf(float f) { unsigned u = __builtin_bit_cast(unsigned, f); return (u + 0x7fffu + ((u >> 16) & 1u)) >> 16; }
__device__ __forceinline__ unsigned pk2(float lo, float hi) { return f2bf(lo) | (f2bf(hi) << 16); }
__device__ __forceinline__ float bf2f(unsigned short h) { return __builtin_bit_cast(float, (unsigned)h << 16); }
__device__ __forceinline__ float bflo(unsigned w) { return __builtin_bit_cast(float, w << 16); }
__device__ __forceinline__ float bfhi(unsigned w) { return __builtin_bit_cast(float, w & 0xffff0000u); }

namespace pg8 {
#define PG8_LAS __attribute__((address_space(3)))
typedef unsigned short bf16_t;
typedef short bf16x8 __attribute__((ext_vector_type(8)));
typedef float f32x4 __attribute__((ext_vector_type(4)));
typedef unsigned u32x4 __attribute__((ext_vector_type(4)));
constexpr int BM = 256, BK = 64, HALF = 128, HTB = HALF * BK * 2  , STAGE_BYTES = 8 * HTB, NXCD = 8, WGM = 8;

__host__ __device__ __forceinline__ int lds_byte(int r, int c) { const int st = (r >> 4) * 2 + (c >> 5), rr = r & 15, cc = c & 31, ob = rr * 64 + cc * 2; return st * 1024 + (ob ^ (((ob >> 9) & 1) << 5)); }
__host__ __device__ __forceinline__ void stage_rc(int b, int& R, int& C) { const int st = b / 1024, sb = b % 1024, swz = sb ^ (((sb >> 9) & 1) << 5); R = (st >> 1) * 16 + swz / 64; C = (st & 1) * 32 + (swz % 64) / 2; }
__host__ __device__ __forceinline__ int perm32(int rho) { const int n = rho >> 4, i = rho & 15; return 8 * (i >> 2) + 4 * n + (i & 3); }

struct Unit { int pm, pn; };
struct Gemm { const bf16_t* A; const bf16_t* Bt; int M, N, K; };

struct StaticOrder {
    int nM, nN, nwg, G, c;
    __host__ __device__ void init(int M, int N, int G_, int c_) { nM = M / BM; nN = N / BM; nwg = nM * nN; G = G_; c = c_; }
    __host__ __device__ bool next(int i, Unit& u) const {
        const long L = (long)i * G + c; if (L >= nwg) return false;
        int wgid = (int)L; { const int q = nwg / NXCD, r = nwg % NXCD, xcd = wgid % NXCD, off = wgid / NXCD; wgid = (xcd < r ? xcd * (q + 1) : r * (q + 1) + (xcd - r) * q) + off; }
        const int nig = WGM * nN, gid = wgid / nig, fm = gid * WGM, gsz = (nM - fm) < WGM ? (nM - fm) : WGM;
        u.pm = fm + ((wgid % nig) % gsz); u.pn = (wgid % nig) / gsz; return true;
    }
    __device__ __forceinline__ void a_ready(const Unit&) const {}
    __device__ __forceinline__ void done(const Unit&) const {}
};

__device__ __forceinline__ unsigned cvt_pk_bf16(float lo, float hi) { unsigned r; asm volatile("v_cvt_pk_bf16_f32 %0, %1, %2" : "=v"(r) : "v"(lo), "v"(hi)); return r; }
template <class Epi, class Sched, bool ALIGN_EPI = false, bool SP2 = false>
__device__ __forceinline__ void gemm_phase(PG8_LAS unsigned char* lds, const Gemm g, const Sched& S, const Epi& E) {
    const int tid = threadIdx.x, wid = __builtin_amdgcn_readfirstlane(tid >> 6), lane = tid & 63, wr = wid >> 2, wc = wid & 3, fr = lane & 15, fq = lane >> 4;
    const int K = g.K, nt = K / BK;
    unsigned voffA[2], voffB[2];
#pragma unroll
    for (int i = 0; i < 2; ++i) { int R, C; stage_rc(tid * 16 + i * 8192, R, C); const int Rb = Epi::PERM ? ((R & ~31) + perm32(R & 31)) : R;
        voffA[i] = (unsigned)(R * K + C) * 2u; voffB[i] = (unsigned)(Rb * K + C) * 2u; }
    const size_t kstep = (size_t)(BK * 2);
    const size_t hstep = (size_t)HALF * K * 2;
    const size_t tstep = 2 * hstep;
    const unsigned ldsw = (unsigned)wid * 1024u;
    const int aoff = lds_byte(wr * 64 + fr, fq * 8), boff = lds_byte(wc * 32 + fr, fq * 8);
#define PG8_SA(b, h) (((b) * 2 + (h)) * HTB)
#define PG8_SB(b, h) ((4 + (b) * 2 + (h)) * HTB)
#define PG8_STAGE(bufoff, gbase, voff) do { _Pragma("unroll") for (int _i = 0; _i < 2; ++_i) \
        __builtin_amdgcn_global_load_lds((const unsigned*)((const char*)(gbase) + (voff)[_i]), (PG8_LAS unsigned*)(lds + (bufoff) + ldsw + _i * 8192), 16, 0, 0); } while (0)
#define PG8_LDA(dst, b, h) do { _Pragma("unroll") for (int m = 0; m < 4; ++m) _Pragma("unroll") for (int k = 0; k < 2; ++k) dst[m][k] = *(const PG8_LAS bf16x8*)(lds + PG8_SA(b, h) + aoff + m * 2048 + k * 1024); } while (0)
#define PG8_LDB(dst, b, h) do { _Pragma("unroll") for (int n = 0; n < 2; ++n) _Pragma("unroll") for (int k = 0; k < 2; ++k) dst[n][k] = *(const PG8_LAS bf16x8*)(lds + PG8_SB(b, h) + boff + n * 2048 + k * 1024); } while (0)
#define PG8_MMA(ai, bj, At, Bt) do { __builtin_amdgcn_s_setprio(1); _Pragma("unroll") for (int m = 0; m < 4; ++m) _Pragma("unroll") for (int n = 0; n < 2; ++n) _Pragma("unroll") for (int k = 0; k < 2; ++k) \
        acc[ai][bj][m][n] = __builtin_amdgcn_mfma_f32_16x16x32_bf16(Bt[n][k], At[m][k], acc[ai][bj][m][n], 0, 0, 0); __builtin_amdgcn_s_setprio(0); } while (0)
#define PG8_WAIT_V(n) asm volatile("s_waitcnt vmcnt(" #n ")" ::: "memory")
#define PG8_WAIT_L(n) asm volatile("s_waitcnt lgkmcnt(" #n ")" ::: "memory")
#define PG8_BAR __builtin_amdgcn_s_barrier()
#define PG8_SCHED __builtin_amdgcn_sched_barrier(0)
    Unit cur, nxt; int ui = 0;
    if (!S.next(0, cur)) return;
    f32x4 acc[2][2][4][2];
#pragma unroll
    for (int a = 0; a < 2; ++a)
#pragma unroll
        for (int b = 0; b < 2; ++b)
#pragma unroll
            for (int m = 0; m < 4; ++m)
#pragma unroll
                for (int n = 0; n < 2; ++n) acc[a][b][m][n] = (f32x4){0.f, 0.f, 0.f, 0.f};
    bf16x8 At[4][2], B0[2][2], B1[2][2];
    const char* cA = (const char*)g.A + (size_t)cur.pm * tstep; const char* cB = (const char*)g.Bt + (size_t)cur.pn * tstep;
    S.a_ready(cur);
    if constexpr (SP2) {
        PG8_STAGE(PG8_SB(0, 0), cB, voffB); PG8_STAGE(PG8_SB(0, 1), cB + hstep, voffB); PG8_STAGE(PG8_SA(0, 0), cA, voffA); PG8_STAGE(PG8_SA(0, 1), cA + hstep, voffA);
        if (wr == 1) PG8_BAR;
        PG8_WAIT_V(2); PG8_BAR;
        PG8_STAGE(PG8_SB(1, 0), cB + kstep, voffB); PG8_STAGE(PG8_SA(1, 0), cA + kstep, voffA); PG8_STAGE(PG8_SB(1, 1), cB + hstep + kstep, voffB);
        PG8_WAIT_V(6); PG8_BAR;
    } else {
        PG8_STAGE(PG8_SB(0, 0), cB, voffB); PG8_STAGE(PG8_SA(0, 0), cA, voffA); PG8_STAGE(PG8_SB(0, 1), cB + hstep, voffB); PG8_STAGE(PG8_SA(0, 1), cA + hstep, voffA);
        if (wr == 1) PG8_BAR;
        PG8_WAIT_V(4); PG8_BAR;
        PG8_STAGE(PG8_SB(1, 0), cB + kstep, voffB); PG8_STAGE(PG8_SA(1, 0), cA + kstep, voffA); PG8_STAGE(PG8_SB(1, 1), cB + hstep + kstep, voffB);
        PG8_WAIT_V(6); PG8_BAR;
    }
    for (;;) {
        const bool has_next = S.next(ui + 1, nxt);
        const char* nA = has_next ? (const char*)g.A + (size_t)nxt.pm * tstep : cA; const char* nB = has_next ? (const char*)g.Bt + (size_t)nxt.pn * tstep : cB;
        for (int t = 0; t < nt; t += 2) {
            const bool last = (t == nt - 2);
            const char* a1 = cA + (size_t)(t + 1) * kstep;
            const char* a2 = last ? nA : cA + (size_t)(t + 2) * kstep; const char* b2 = last ? nB : cB + (size_t)(t + 2) * kstep;
            const char* a3 = a2 + kstep; const char* b3 = b2 + kstep;
            if (last && has_next) S.a_ready(nxt);
            if constexpr (SP2) {
            PG8_LDB(B0, 0, 0); PG8_LDB(B1, 0, 1); PG8_SCHED; PG8_LDA(At, 0, 0); PG8_STAGE(PG8_SA(1, 1), a1 + hstep, voffA);
            PG8_WAIT_V(8); PG8_WAIT_L(0); PG8_BAR; PG8_MMA(0, 0, At, B0); PG8_MMA(0, 1, At, B1); PG8_BAR; PG8_SCHED;
            PG8_LDA(At, 0, 1); PG8_STAGE(PG8_SB(0, 0), b2, voffB); PG8_STAGE(PG8_SB(0, 1), b2 + hstep, voffB); PG8_STAGE(PG8_SA(0, 0), a2, voffA);
            PG8_WAIT_V(8); PG8_WAIT_L(0); PG8_BAR; PG8_MMA(1, 0, At, B0); PG8_MMA(1, 1, At, B1); PG8_BAR; PG8_SCHED;
            PG8_LDB(B0, 1, 0); PG8_LDB(B1, 1, 1); PG8_SCHED; PG8_LDA(At, 1, 0); PG8_STAGE(PG8_SA(0, 1), a2 + hstep, voffA);
            PG8_WAIT_V(8); PG8_WAIT_L(0); PG8_BAR; PG8_MMA(0, 0, At, B0); PG8_MMA(0, 1, At, B1); PG8_BAR; PG8_SCHED;
            PG8_LDA(At, 1, 1); PG8_STAGE(PG8_SB(1, 0), b3, voffB); PG8_STAGE(PG8_SB(1, 1), b3 + hstep, voffB); PG8_STAGE(PG8_SA(1, 0), a3, voffA);
            PG8_WAIT_V(8); PG8_WAIT_L(0); PG8_BAR; PG8_MMA(1, 0, At, B0); PG8_MMA(1, 1, At, B1); PG8_BAR; PG8_SCHED;
            } else {
            PG8_LDB(B0, 0, 0); PG8_SCHED; PG8_LDA(At, 0, 0); PG8_STAGE(PG8_SA(1, 1), a1 + hstep, voffA);
            PG8_WAIT_L(8); PG8_BAR; PG8_WAIT_L(0); PG8_MMA(0, 0, At, B0); PG8_BAR; PG8_SCHED;
            PG8_LDB(B1, 0, 1); PG8_STAGE(PG8_SB(0, 0), b2, voffB);
            PG8_BAR; PG8_WAIT_L(0); PG8_MMA(0, 1, At, B1); PG8_BAR;
            PG8_LDA(At, 0, 1); PG8_STAGE(PG8_SA(0, 0), a2, voffA);
            PG8_BAR; PG8_WAIT_L(0); PG8_MMA(1, 0, At, B0); PG8_BAR; PG8_SCHED;
            PG8_STAGE(PG8_SB(0, 1), b2 + hstep, voffB);
            PG8_WAIT_V(6); PG8_BAR; PG8_MMA(1, 1, At, B1); PG8_BAR;
            PG8_LDB(B0, 1, 0); PG8_SCHED; PG8_LDA(At, 1, 0); PG8_STAGE(PG8_SA(0, 1), a2 + hstep, voffA);
            PG8_WAIT_L(8); PG8_BAR; PG8_WAIT_L(0); PG8_MMA(0, 0, At, B0); PG8_BAR; PG8_SCHED;
            PG8_LDB(B1, 1, 1); PG8_STAGE(PG8_SB(1, 0), b3, voffB);
            PG8_BAR; PG8_WAIT_L(0); PG8_MMA(0, 1, At, B1); PG8_BAR;
            PG8_LDA(At, 1, 1); PG8_STAGE(PG8_SA(1, 0), a3, voffA);
            PG8_BAR; PG8_WAIT_L(0); PG8_MMA(1, 0, At, B0); PG8_BAR; PG8_SCHED;
            PG8_STAGE(PG8_SB(1, 1), b3 + hstep, voffB);
            PG8_WAIT_V(6); PG8_BAR; PG8_MMA(1, 1, At, B1); PG8_BAR;
            }
        }
        if constexpr (ALIGN_EPI) { if (wr == 0) PG8_BAR; }
        if constexpr (!Epi::AFTER_DRAIN) { E(acc, cur, wr, wc, fr, fq); S.done(cur); }
        if (!has_next) break;
#pragma unroll
        for (int a = 0; a < 2; ++a)
#pragma unroll
            for (int b = 0; b < 2; ++b)
#pragma unroll
                for (int m = 0; m < 4; ++m)
#pragma unroll
                    for (int n = 0; n < 2; ++n) acc[a][b][m][n] = (f32x4){0.f, 0.f, 0.f, 0.f};
        cur = nxt; cA = nA; cB = nB; ++ui;
        if constexpr (ALIGN_EPI) { if (wr == 1) PG8_BAR; }
    }
    PG8_WAIT_V(0);
    if constexpr (!ALIGN_EPI) { if (wr == 0) PG8_BAR; }
    PG8_BAR;
    if constexpr (Epi::AFTER_DRAIN) { E.fused(acc, cur, wr, wc, fr, fq, lds, wid, lane); S.done(cur); }
#undef PG8_SA
#undef PG8_SB
#undef PG8_STAGE
#undef PG8_LDA
#undef PG8_LDB
#undef PG8_MMA
#undef PG8_WAIT_V
#undef PG8_WAIT_L
#undef PG8_BAR
#undef PG8_SCHED
}
}

#ifndef PG8_SP2
#define PG8_SP2 true
#endif
#ifndef PG8_ALIGN
#define PG8_ALIGN true
#endif

namespace mk {
using pg8::f32x4; using pg8::bf16x8; using pg8::u32x4; using pg8::Unit; using pg8::Gemm; using pg8::bf16_t; using pg8::cvt_pk_bf16; using pg8::perm32;
typedef unsigned u32x2 __attribute__((ext_vector_type(2)));
constexpr int BM = 256, HALF = 128;

__device__ __forceinline__ float row_rstd(const float* RS, int row) {
    const f32x4 p = *(const f32x4*)(RS + (size_t)row * 4);
    return rsqrtf(((p[0] + p[1]) + (p[2] + p[3])) * (1.0f / D) + NORM_EPS);
}
__device__ __forceinline__ float silu_mul(float g, float u) {
    const float e = __builtin_amdgcn_exp2f(-g * LOG2E);
    return g * u * __builtin_amdgcn_rcpf(1.0f + e);
}
__device__ __forceinline__ float log_sigmoid(float x) { return fminf(x, 0.f) - log1pf(__expf(-fabsf(x))); }

struct RoundOrder : pg8::StaticOrder {
    int rnd;
    __device__ __forceinline__ bool next(int i, Unit& u) const { if (i > 0) return false; return pg8::StaticOrder::next(rnd, u); }
};

struct EpiSwiglu {
    static constexpr bool PERM = true, AFTER_DRAIN = false;
    bf16_t* Hout; const float* RS;
    __device__ __forceinline__ void operator()(const f32x4 (&acc)[2][2][4][2], const Unit& u, int wr, int wc, int fr, int fq) const {
        const int row0 = u.pm * BM + wr * 64 + fr, col0 = u.pn * HALF + wc * 32 + 8 * fq;
#pragma unroll
        for (int ai = 0; ai < 2; ++ai)
#pragma unroll
            for (int m = 0; m < 4; ++m) {
                const int row = row0 + ai * HALF + m * 16; const float r = row_rstd(RS, row);
                const f32x4 g0 = acc[ai][0][m][0] * r, g1 = acc[ai][0][m][1] * r, u0 = acc[ai][1][m][0] * r, u1 = acc[ai][1][m][1] * r;
                u32x4 w;
                w.x = cvt_pk_bf16(silu_mul(g0[0], u0[0]), silu_mul(g0[1], u0[1])); w.y = cvt_pk_bf16(silu_mul(g0[2], u0[2]), silu_mul(g0[3], u0[3]));
                w.z = cvt_pk_bf16(silu_mul(g1[0], u1[0]), silu_mul(g1[1], u1[1])); w.w = cvt_pk_bf16(silu_mul(g1[2], u1[2]), silu_mul(g1[3], u1[3]));
                *(u32x4*)(Hout + (size_t)row * FF + col0) = w;
            }
    }
};

struct EpiRes {
    static constexpr bool PERM = false, AFTER_DRAIN = true;
    const float* base_p; const float* base_s; float* X; bf16_t* XB; float* RS; float scale;
    __device__ __forceinline__ void fused(f32x4 (&acc)[2][2][4][2], const Unit& u, int wr, int wc, int fr, int fq, PG8_LAS unsigned char* lds, int wid, int lane) const {
        PG8_LAS float* P = (PG8_LAS float*)lds;
        const int col0 = u.pn * BM + wc * 32 + 4 * fq;
#pragma unroll
        for (int ai = 0; ai < 2; ++ai)
#pragma unroll
            for (int m = 0; m < 4; ++m) {
                const int rl = ai * HALF + wr * 64 + m * 16 + fr, row = u.pm * BM + rl;
                const float* bp = row < MP ? base_p + (size_t)row * D : base_s + (size_t)(row - MP) * D;
                float ss = 0.f;
#pragma unroll
                for (int bj = 0; bj < 2; ++bj)
#pragma unroll
                    for (int n = 0; n < 2; ++n) {
                        const int c = col0 + bj * HALF + n * 16;
                        const f32x4 b = *(const f32x4*)(bp + c); const f32x4 v = b + acc[ai][bj][m][n] * scale;
                        *(f32x4*)(X + (size_t)row * D + c) = v;
                        u32x2 w; w.x = cvt_pk_bf16(v[0], v[1]); w.y = cvt_pk_bf16(v[2], v[3]);
                        *(u32x2*)(XB + (size_t)row * D + c) = w;
                        ss += (v[0] * v[0] + v[1] * v[1]) + (v[2] * v[2] + v[3] * v[3]);
                    }
                ss += __shfl_xor(ss, 16); ss += __shfl_xor(ss, 32);
                if (fq == 0) P[rl * 4 + wc] = ss;
                if (m & 1) asm volatile("" ::: "memory");
            }
        asm volatile("s_waitcnt lgkmcnt(0)" ::: "memory"); __builtin_amdgcn_s_barrier(); asm volatile("" ::: "memory");
        const int t = wid * 64 + lane;
        if (t < 256) { const f32x4 p = *(const PG8_LAS f32x4*)(P + t * 4); RS[(size_t)(u.pm * BM + t) * 4 + u.pn] = (p[0] + p[1]) + (p[2] + p[3]); }
        asm volatile("s_waitcnt lgkmcnt(0)" ::: "memory"); __builtin_amdgcn_s_barrier(); asm volatile("" ::: "memory");
    }
};

struct EpiConvIn {
    static constexpr bool PERM = true, AFTER_DRAIN = false;
    bf16_t* G; bf16_t* U; const float* RS; float* cs_p; float* cs_s;
    __device__ __forceinline__ void operator()(const f32x4 (&acc)[2][2][4][2], const Unit& u, int wr, int wc, int fr, int fq) const {
        const int row0 = u.pm * BM + wr * 64 + fr;
        if (u.pn < 4) {
            const int col0 = u.pn * BM + wc * 32 + 8 * fq;
#pragma unroll
            for (int ai = 0; ai < 2; ++ai)
#pragma unroll
                for (int m = 0; m < 4; ++m) {
                    const int row = row0 + ai * HALF + m * 16; const float r = row_rstd(RS, row);
#pragma unroll
                    for (int bj = 0; bj < 2; ++bj) { const f32x4 v0 = acc[ai][bj][m][0] * r, v1 = acc[ai][bj][m][1] * r;
                        u32x4 w; w.x = cvt_pk_bf16(v0[0], v0[1]); w.y = cvt_pk_bf16(v0[2], v0[3]); w.z = cvt_pk_bf16(v1[0], v1[1]); w.w = cvt_pk_bf16(v1[2], v1[3]);
                        *(u32x4*)(G + (size_t)row * D + col0 + bj * HALF) = w; }
                }
        } else {
            const int col0 = (u.pn - 4) * HALF + wc * 32 + 8 * fq;
#pragma unroll
            for (int ai = 0; ai < 2; ++ai)
#pragma unroll
                for (int m = 0; m < 4; ++m) {
                    const int row = row0 + ai * HALF + m * 16; const float r = row_rstd(RS, row), r2 = r * r;
                    const f32x4 v0 = acc[ai][0][m][0] * acc[ai][1][m][0] * r2, v1 = acc[ai][0][m][1] * acc[ai][1][m][1] * r2;
                    u32x4 w; w.x = cvt_pk_bf16(v0[0], v0[1]); w.y = cvt_pk_bf16(v0[2], v0[3]); w.z = cvt_pk_bf16(v1[0], v1[1]); w.w = cvt_pk_bf16(v1[2], v1[3]);
                    *(u32x4*)(U + (size_t)row * D + col0) = w;
                    float* cs = nullptr;
                    if (row < MP) { const int t = row & (SEQ - 1); if (t >= SEQ - 2) cs = cs_p + ((size_t)(row >> 11) * 2 + (t - (SEQ - 2))) * D; }
                    else { const int rr = row - MP, t = rr & (DSEQ - 1); if (t >= DSEQ - 2) cs = cs_s + ((size_t)(rr >> 6) * 2 + (t - (DSEQ - 2))) * D; }
                    if (cs) { *(f32x4*)(cs + col0) = v0; *(f32x4*)(cs + col0 + 4) = v1; }
                }
        }
    }
};

struct EpiAttnIn {
    static constexpr bool PERM = true, AFTER_DRAIN = false;
    bf16_t *Qb, *Kb, *Vb; const float* RS; const float *gq, *gk, *bfg; float *k_p, *k_s, *v_p, *v_s, *lf_p, *lf_s;
    __device__ __forceinline__ void operator()(const f32x4 (&acc)[2][2][4][2], const Unit& u, int wr, int wc, int fr, int fq) const {
        const int row0 = u.pm * BM + wr * 64 + fr, pn = u.pn;
        if (pn < 8) {
            const bool isq = pn < 4; const float* gg = isq ? gq : gk;
            f32x4 gv[2][2];
#pragma unroll
            for (int bj = 0; bj < 2; ++bj)
#pragma unroll
                for (int n = 0; n < 2; ++n) gv[bj][n] = *(const f32x4*)(gg + 32 * bj + 8 * fq + 4 * n);
            const int hcol = ((pn & 3) * 4 + wc) * HD + 8 * fq;
#pragma unroll
            for (int ai = 0; ai < 2; ++ai)
#pragma unroll
                for (int m = 0; m < 4; ++m) {
                    const int row = row0 + ai * HALF + m * 16; const float r = row_rstd(RS, row);
                    float ss = 0.f;
#pragma unroll
                    for (int bj = 0; bj < 2; ++bj)
#pragma unroll
                        for (int n = 0; n < 2; ++n) { const f32x4 a = acc[ai][bj][m][n]; ss += (a[0] * a[0] + a[1] * a[1]) + (a[2] * a[2] + a[3] * a[3]); }
                    ss += __shfl_xor(ss, 16); ss += __shfl_xor(ss, 32);
                    const float f = r * rsqrtf(r * r * ss * (1.0f / HD) + NORM_EPS);
                    float* ko = nullptr; if (!isq) ko = (row < MP ? k_p + (size_t)row * D : k_s + (size_t)(row - MP) * D) + hcol;
#pragma unroll
                    for (int bj = 0; bj < 2; ++bj) {
                        const f32x4 o0 = acc[ai][bj][m][0] * f * gv[bj][0], o1 = acc[ai][bj][m][1] * f * gv[bj][1];
                        if (isq) { const f32x4 s0 = o0 * QSCALE, s1 = o1 * QSCALE;
                            u32x4 w; w.x = cvt_pk_bf16(s0[0], s0[1]); w.y = cvt_pk_bf16(s0[2], s0[3]); w.z = cvt_pk_bf16(s1[0], s1[1]); w.w = cvt_pk_bf16(s1[2], s1[3]);
                            *(u32x4*)(Qb + (size_t)row * D + hcol + 32 * bj) = w; }
                        else { u32x4 w; w.x = cvt_pk_bf16(o0[0], o0[1]); w.y = cvt_pk_bf16(o0[2], o0[3]); w.z = cvt_pk_bf16(o1[0], o1[1]); w.w = cvt_pk_bf16(o1[2], o1[3]);
                            *(u32x4*)(Kb + (size_t)row * D + hcol + 32 * bj) = w;
                            *(f32x4*)(ko + 32 * bj) = o0; *(f32x4*)(ko + 32 * bj + 4) = o1; }
                    }
                }
        } else if (pn < 12) {
            const int col0 = (pn - 8) * BM + wc * 32 + 8 * fq;
#pragma unroll
            for (int ai = 0; ai < 2; ++ai)
#pragma unroll
                for (int m = 0; m < 4; ++m) {
                    const int row = row0 + ai * HALF + m * 16; const float r = row_rstd(RS, row);
                    float* vo = (row < MP ? v_p + (size_t)row * D : v_s + (size_t)(row - MP) * D) + col0;
#pragma unroll
                    for (int bj = 0; bj < 2; ++bj) { const f32x4 o0 = acc[ai][bj][m][0] * r, o1 = acc[ai][bj][m][1] * r;
                        u32x4 w; w.x = cvt_pk_bf16(o0[0], o0[1]); w.y = cvt_pk_bf16(o0[2], o0[3]); w.z = cvt_pk_bf16(o1[0], o1[1]); w.w = cvt_pk_bf16(o1[2], o1[3]);
                        *(u32x4*)(Vb + (size_t)row * D + col0 + bj * HALF) = w;
                        *(f32x4*)(vo + bj * HALF) = o0; *(f32x4*)(vo + bj * HALF + 4) = o1; }
                }
        } else {
            if (wc == 0 && fq < 2) {
                const f32x4 b0 = *(const f32x4*)(bfg + 8 * fq), b1 = *(const f32x4*)(bfg + 8 * fq + 4);
#pragma unroll
                for (int ai = 0; ai < 2; ++ai)
#pragma unroll
                    for (int m = 0; m < 4; ++m) {
                        const int row = row0 + ai * HALF + m * 16; const float r = row_rstd(RS, row);
                        float* lo = (row < MP ? lf_p + (size_t)row * NH : lf_s + (size_t)(row - MP) * NH) + 8 * fq;
                        const f32x4 a0 = acc[ai][0][m][0] * r + b0, a1 = acc[ai][0][m][1] * r + b1;
                        f32x4 l0, l1;
#pragma unroll
                        for (int j = 0; j < 4; ++j) { l0[j] = log_sigmoid(a0[j]); l1[j] = log_sigmoid(a1[j]); }
                        *(f32x4*)lo = l0; *(f32x4*)(lo + 4) = l1;
                    }
            }
        }
    }
};

template <class Epi, class Sched>
__device__ __forceinline__ void gemm_phase_simple(PG8_LAS unsigned char* lds, const Gemm g, const Sched& S, const Epi& E) {
    const int tid = threadIdx.x, wid = __builtin_amdgcn_readfirstlane(tid >> 6), lane = tid & 63, wr = wid >> 2, wc = wid & 3, fr = lane & 15, fq = lane >> 4;
    const int K = g.K;
    Unit cur;
    for (int ui = 0; S.next(ui, cur); ++ui) {
        f32x4 acc[2][2][4][2];
#pragma unroll
        for (int a = 0; a < 2; ++a)
#pragma unroll
            for (int b = 0; b < 2; ++b)
#pragma unroll
                for (int m = 0; m < 4; ++m)
#pragma unroll
                    for (int n = 0; n < 2; ++n) acc[a][b][m][n] = (f32x4){0.f, 0.f, 0.f, 0.f};
        const bf16_t* Ab = g.A + (size_t)(cur.pm * BM + wr * 64 + fr) * K + fq * 8;
        const bf16_t* Bb = g.Bt + (size_t)(cur.pn * BM + wc * 32) * K + fq * 8;
        const int br0 = Epi::PERM ? perm32(fr) : fr, br1 = Epi::PERM ? perm32(16 + fr) : 16 + fr;
        for (int kt = 0; kt < K; kt += 32) {
            bf16x8 a[2][4], b[2][2];
#pragma unroll
            for (int ai = 0; ai < 2; ++ai)
#pragma unroll
                for (int m = 0; m < 4; ++m) a[ai][m] = *(const bf16x8*)(Ab + (size_t)(ai * HALF + m * 16) * K + kt);
#pragma unroll
            for (int bj = 0; bj < 2; ++bj) { b[bj][0] = *(const bf16x8*)(Bb + (size_t)(bj * HALF + br0) * K + kt); b[bj][1] = *(const bf16x8*)(Bb + (size_t)(bj * HALF + br1) * K + kt); }
#pragma unroll
            for (int ai = 0; ai < 2; ++ai)
#pragma unroll
                for (int bj = 0; bj < 2; ++bj)
#pragma unroll
                    for (int m = 0; m < 4; ++m)
#pragma unroll
                        for (int n = 0; n < 2; ++n) acc[ai][bj][m][n] = __builtin_amdgcn_mfma_f32_16x16x32_bf16(b[bj][n], a[ai][m], acc[ai][bj][m][n], 0, 0, 0);
        }
        if constexpr (Epi::AFTER_DRAIN) { __syncthreads(); E.fused(acc, cur, wr, wc, fr, fq, lds, wid, lane); __syncthreads(); }
        else E(acc, cur, wr, wc, fr, fq);
    }
}
}
#define XB_TMO      128
#define XB_XCNT(j)  (256  + 64 * (j))
#define XB_XSUB(j)  (1280 + 64 * (j))
#define XB_XGEN(j)  (2304 + 64 * (j))
#define XB_TOP      3328
#define XB_TOPGEN   3392
#define XCD_BAR_WORDS 3456
#define XB_SPIN_CAP (1u << 18)

__device__ __forceinline__ unsigned xb_ld(unsigned* p)              { return __hip_atomic_load(p, __ATOMIC_RELAXED, __HIP_MEMORY_SCOPE_AGENT); }
__device__ __forceinline__ unsigned xb_add(unsigned* p, unsigned v) { return __hip_atomic_fetch_add(p, v, __ATOMIC_RELAXED, __HIP_MEMORY_SCOPE_AGENT); }
__device__ __forceinline__ unsigned xb_xcc_id() { return (unsigned)__builtin_amdgcn_s_getreg((3 << 11) | 20) & 0xFu; }
#define XB_SPIN(cond, bar) do { unsigned _sp = 0; while (cond) { __builtin_amdgcn_s_sleep(1); \
    if ((++_sp & 255u) == 0u) { if (xb_ld(&(bar)[XB_TMO])) break; if (_sp > XB_SPIN_CAP) { atomicAdd(&(bar)[XB_TMO], 1u); break; } } } } while (0)

struct XcdBarrier {
    unsigned* bar; unsigned x;
    volatile LAS unsigned* st;
};

__device__ __forceinline__ XcdBarrier xcd_barrier_post(unsigned* bar, volatile LAS unsigned* st) {
    XcdBarrier b; b.bar = bar; b.x = xb_xcc_id(); b.st = st;
    if (threadIdx.x == 0) (void)xb_add(&bar[XB_XCNT(b.x)], 1u);
    return b;
}
__device__ __forceinline__ void xcd_barrier_complete(unsigned* bar, unsigned x, unsigned& nloc, unsigned& nx) {
    const unsigned G = gridDim.x * gridDim.y * gridDim.z;
    unsigned sum, cnt, mine, sp = 0u;
    for (;;) {
        sum = 0u; cnt = 0u; mine = 0u;
#pragma unroll
        for (unsigned j = 0; j < 16; ++j) { const unsigned c = xb_ld(&bar[XB_XCNT(j)]); sum += c; cnt += (c > 0u) ? 1u : 0u; mine = (j == x) ? c : mine; }
        if (sum == G) break;
        __builtin_amdgcn_s_sleep(1);
        if ((++sp & 255u) == 0u) { if (xb_ld(&bar[XB_TMO])) break; if (sp > XB_SPIN_CAP) { atomicAdd(&bar[XB_TMO], 1u); break; } }
    }
    nloc = mine > 0u ? mine : 1u; nx = cnt > 0u ? cnt : 1u;
}

__device__ __forceinline__ void xcd_barrier(const XcdBarrier& b) {
    asm volatile("s_waitcnt vmcnt(0)" ::: "memory");
    __syncthreads();
    if (threadIdx.x == 0) {
        unsigned* bar = b.bar;
        __builtin_amdgcn_s_waitcnt(0);
        unsigned nloc = b.st[0], nx = b.st[1];
        if (nloc == 0u) { xcd_barrier_complete(bar, b.x, nloc, nx); b.st[0] = nloc; b.st[1] = nx; }
        const unsigned old = xb_add(&bar[XB_XSUB(b.x)], 1u);
        const unsigned gen = old / nloc;
        if (old + 1u == (gen + 1u) * nloc) {
            __builtin_amdgcn_fence(__ATOMIC_RELEASE, "agent");
            asm volatile("s_waitcnt vmcnt(0)" ::: "memory");
            const unsigned og = xb_add(&bar[XB_TOP], 1u);
            const unsigned tg = og / nx;
            if (og + 1u == (tg + 1u) * nx) xb_add(&bar[XB_TOPGEN], 1u);
            else XB_SPIN(xb_ld(&bar[XB_TOPGEN]) == tg, bar);
            __builtin_amdgcn_fence(__ATOMIC_ACQUIRE, "agent");
            xb_add(&bar[XB_XGEN(b.x)], 1u);
            asm volatile("s_waitcnt vmcnt(0)" ::: "memory");
        } else {
            XB_SPIN(xb_ld(&bar[XB_XGEN(b.x)]) == gen, bar);
            __builtin_amdgcn_fence(__ATOMIC_ACQUIRE, "agent");
            asm volatile("s_waitcnt vmcnt(0)" ::: "memory");
        }
    }
    __syncthreads();
}

struct Frame {
    LAS unsigned char* lds;
    volatile LAS unsigned* MISC;
    gu32* ctl;
    int tid, lane, wave, vcu, G;
    const float *x_p, *x_s, *state_conv, *cache_k, *cache_v, *cache_lf, *norm_ffn, *ffn_w_in, *ffn_w_out, *norm_mix, *conv_w_in, *conv_w, *conv_w_out, *attn_w_in, *attn_bf, *q_norm, *k_norm, *attn_w_out;
    float* out; unsigned char* ws;
};
__device__ __forceinline__ bf16* ws_bf(const Frame& F, size_t off) { return (bf16*)(F.ws + off); }

__device__ __forceinline__ float wave_sum(float v) {
#pragma unroll
    for (int o = 1; o < 64; o <<= 1) v += __shfl_xor(v, o);
    return v;
}

__device__ __forceinline__ void wprep_item(const float* W, int ldw, int K, const float* gain, int col0, int nvalid, bf16* WT, int dst_row0, int kb, LAS float* scr, int lane) {
    const int k0 = 64 * kb, c = lane & 31;
#pragma unroll 8
    for (int i = 0; i < 32; ++i) { const int kk = 2 * i + (lane >> 5); float v = 0.f; if (c < nvalid) v = W[(size_t)(k0 + kk) * ldw + col0 + c]; if (gain) v *= gain[k0 + kk]; scr[kk * 33 + c] = v; }
    LDS_WAIT(); asm volatile("" ::: "memory");
    const int c8 = lane & 7;
#pragma unroll
    for (int j = 0; j < 4; ++j) { const int n = (lane >> 3) + 8 * j; const LAS float* s = scr + (8 * c8) * 33 + n;
        v4u o; o.x = pk2(s[0 * 33], s[1 * 33]); o.y = pk2(s[2 * 33], s[3 * 33]); o.z = pk2(s[4 * 33], s[5 * 33]); o.w = pk2(s[6 * 33], s[7 * 33]);
        *(GAS v4u*)(WT + (size_t)(dst_row0 + n) * K + k0 + 8 * c8) = o; }
    LDS_WAIT(); asm volatile("" ::: "memory");
}
__device__ __forceinline__ int pair_col(int g, int base, int half_off) { const int tile = g >> 3, bj = (g >> 2) & 1, i = g & 3; return base + bj * half_off + 128 * tile + 32 * i; }
__device__ __forceinline__ int head_col(int g) { const int tile = g >> 3, bj = (g >> 2) & 1, wc = g & 3; return 256 * tile + 64 * wc + 32 * bj; }

__device__ __forceinline__ void p0_prologue(Frame& F) {
    LAS float* scr = (LAS float*)(F.lds + RING_OFF + F.wave * 16384);
    const int gw = F.vcu * NWAVES + F.wave, NGW = F.G * NWAVES, lane = F.lane;
    constexpr int KB1 = D / 64, KB2 = FF / 64;
    constexpr int I_FFI = (2 * FF / 32) * KB1, I_FFO = (D / 32) * KB2;
    constexpr int I_CI1 = 32 * KB1, I_CI2 = 64 * KB1, I_CO = 32 * KB1, I_AQK = 64 * KB1, I_AV = 32 * KB1, I_AF = 8 * KB1, I_AO = 32 * KB1;
    constexpr int NITEMS = 4 * I_FFI + 4 * I_FFO + I_CI1 + I_CI2 + I_CO + I_AQK + I_AV + I_AF + I_AO;
    for (int it = gw; it < NITEMS; it += NGW) {
        int r = it;
        if (r < 4 * I_FFI) { const int w = r / I_FFI; r -= w * I_FFI; const int g = r / KB1, kb = r % KB1;
            wprep_item(F.ffn_w_in + (size_t)w * D * 2 * FF, 2 * FF, D, F.norm_ffn + w * D, pair_col(g, 0, FF), 32, ws_bf(F, WS_FFI + w * SZ_FFI), 32 * g, kb, scr, lane); continue; }
        r -= 4 * I_FFI;
        if (r < 4 * I_FFO) { const int w = r / I_FFO; r -= w * I_FFO; const int g = r / KB2, kb = r % KB2;
            wprep_item(F.ffn_w_out + (size_t)w * FF * D, D, FF, nullptr, 32 * g, 32, ws_bf(F, WS_FFO + w * SZ_FFO), 32 * g, kb, scr, lane); continue; }
        r -= 4 * I_FFO;
        if (r < I_CI1) { const int g = r / KB1, kb = r % KB1; wprep_item(F.conv_w_in, 3 * D, D, F.norm_mix, 32 * g, 32, ws_bf(F, WS_CI), 32 * g, kb, scr, lane); continue; }
        r -= I_CI1;
        if (r < I_CI2) { const int g = r / KB1, kb = r % KB1; wprep_item(F.conv_w_in, 3 * D, D, F.norm_mix, pair_col(g, D, D), 32, ws_bf(F, WS_CI), D + 32 * g, kb, scr, lane); continue; }
        r -= I_CI2;
        if (r < I_CO) { const int g = r / KB1, kb = r % KB1; wprep_item(F.conv_w_out, D, D, nullptr, 32 * g, 32, ws_bf(F, WS_CO), 32 * g, kb, scr, lane); continue; }
        r -= I_CO;
        if (r < I_AQK) { const int g = r / KB1, kb = r % KB1; wprep_item(F.attn_w_in, 3 * D + NH, D, F.norm_mix + D, head_col(g), 32, ws_bf(F, WS_AI), 32 * g, kb, scr, lane); continue; }
        r -= I_AQK;
        if (r < I_AV) { const int g = r / KB1, kb = r % KB1; wprep_item(F.attn_w_in, 3 * D + NH, D, F.norm_mix + D, 2 * D + 32 * g, 32, ws_bf(F, WS_AI), 2 * D + 32 * g, kb, scr, lane); continue; }
        r -= I_AV;
        if (r < I_AF) { const int g = r / KB1, kb = r % KB1; wprep_item(F.attn_w_in, 3 * D + NH, D, F.norm_mix + D, 3 * D, g == 0 ? NH : 0, ws_bf(F, WS_AI), 3 * D + 32 * g, kb, scr, lane); continue; }
        r -= I_AF;
        { const int g = r / KB1, kb = r % KB1; wprep_item(F.attn_w_out, D, D, nullptr, 32 * g, 32, ws_bf(F, WS_AO), 32 * g, kb, scr, lane); }
    }
    bf16* XB = ws_bf(F, WS_XB); float* RS = (float*)(F.ws + WS_RS);
    for (int m = gw; m < M; m += NGW) {
        const float* src = m < MP ? F.x_p + (size_t)m * D : F.x_s + (size_t)(m - MP) * D;
        const GAS pg8::f32x4* xr = (const GAS pg8::f32x4*)src + lane; float ss = 0.f;
        GAS unsigned long long* o8 = (GAS unsigned long long*)(XB + (size_t)m * D) + lane;
#pragma unroll
        for (int j = 0; j < 4; ++j) { const pg8::f32x4 v = xr[64 * j]; ss += (v[0] * v[0] + v[1] * v[1]) + (v[2] * v[2] + v[3] * v[3]);
            o8[64 * j] = (unsigned long long)pk2(v[0], v[1]) | ((unsigned long long)pk2(v[2], v[3]) << 32); }
        ss = wave_sum(ss);
        if (lane == 0) *(pg8::f32x4*)(RS + (size_t)m * 4) = (pg8::f32x4){ss, 0.f, 0.f, 0.f};
    }
}

__device__ __forceinline__ void unpack8(const v4u w, float (&f)[8]) { f[0] = bflo(w.x); f[1] = bfhi(w.x); f[2] = bflo(w.y); f[3] = bfhi(w.y); f[4] = bflo(w.z); f[5] = bfhi(w.z); f[6] = bflo(w.w); f[7] = bfhi(w.w); }
__device__ __forceinline__ void conv_ew_phase(Frame& F) {
    bf16* G = ws_bf(F, WS_BIG); const bf16* U = ws_bf(F, WS_BIG + SZ_ACT);
    const int gw = F.vcu * NWAVES + F.wave, NGW = F.G * NWAVES, lane = F.lane;
    constexpr int RCH = 16, NITEMS = (M / RCH) * 2;
    for (int it = gw; it < NITEMS; it += NGW) {
        const int r0 = (it >> 1) * RCH, c = (it & 1) * 512 + lane * 8;
        float w0[8], w1[8], w2[8], um2[8], um1[8];
#pragma unroll
        for (int j = 0; j < 8; ++j) { w0[j] = F.conv_w[c + j]; w1[j] = F.conv_w[D + c + j]; w2[j] = F.conv_w[2 * D + c + j]; }
        int t0, b; bool prompt = r0 < MP;
        if (prompt) { t0 = r0 & (SEQ - 1); b = r0 >> 11; } else { t0 = (r0 - MP) & (DSEQ - 1); b = (r0 - MP) >> 6; }
        if (t0 == 0) {
            if (prompt) {
#pragma unroll
                for (int j = 0; j < 8; ++j) { um2[j] = 0.f; um1[j] = 0.f; }
            } else {
#pragma unroll
                for (int j = 0; j < 8; ++j) { um2[j] = F.state_conv[((size_t)b * 2 + 0) * D + c + j]; um1[j] = F.state_conv[((size_t)b * 2 + 1) * D + c + j]; }
            }
        } else {
            unpack8(*(const GAS v4u*)(U + (size_t)(r0 - 2) * D + c), um2); unpack8(*(const GAS v4u*)(U + (size_t)(r0 - 1) * D + c), um1);
        }
        for (int i = 0; i < RCH; ++i) {
            float uc[8], gg[8], z[8];
            unpack8(*(const GAS v4u*)(U + (size_t)(r0 + i) * D + c), uc); unpack8(*(const GAS v4u*)(G + (size_t)(r0 + i) * D + c), gg);
#pragma unroll
            for (int j = 0; j < 8; ++j) { z[j] = gg[j] * (w0[j] * um2[j] + w1[j] * um1[j] + w2[j] * uc[j]); um2[j] = um1[j]; um1[j] = uc[j]; }
            v4u o; o.x = pk2(z[0], z[1]); o.y = pk2(z[2], z[3]); o.z = pk2(z[4], z[5]); o.w = pk2(z[6], z[7]);
            *(GAS v4u*)(G + (size_t)(r0 + i) * D + c) = o;
        }
    }
}

__device__ __forceinline__ void cumsum_table(const float* s1, int n1, const float* s2, int n2, LAS float* tab, LAS float* wsum, int tid) {
    const int lane = tid & 63, wid = tid >> 6;
    float v[5]; float run = 0.f;
#pragma unroll
    for (int j = 0; j < 5; ++j) { const int e = 5 * tid + j; float x = 0.f; if (e < n1) x = s1[(size_t)e * NH]; else if (e < n1 + n2) x = s2[(size_t)(e - n1) * NH]; run += x; v[j] = run; }
    float sc = run;
#pragma unroll
    for (int o = 1; o < 64; o <<= 1) { const float t = __shfl_up(sc, o); if (lane >= o) sc += t; }
    if (lane == 63) wsum[wid] = sc;
    __syncthreads();
    float off = 0.f;
    for (int w = 0; w < wid; ++w) off += wsum[w];
    const float excl = off + sc - run;
#pragma unroll
    for (int j = 0; j < 5; ++j) { const int e = 5 * tid + j; if (e < n1 + n2) tab[e] = -(excl + v[j]) * LOG2E; }
    __syncthreads();
}

__device__ __forceinline__ void attn_simple_phase(Frame& F) {
    bf16* Qb = ws_bf(F, WS_BIG); const bf16* Kb = ws_bf(F, WS_BIG + SZ_ACT); const bf16* Vb = ws_bf(F, WS_BIG + 2 * SZ_ACT);
    LAS float* tab = (LAS float*)(F.lds + RING_OFF); LAS float* wsum = (LAS float*)(F.lds + RING_OFF + 16384);
    const int lane = F.lane;
    for (int bh = F.vcu >> 1; bh < NB * NH; bh += F.G >> 1) {
        const int b = bh >> 4, h = bh & 15, half = F.vcu & 1;
        __syncthreads();
        cumsum_table(F.out + O_LFP + (size_t)b * SEQ * NH + h, SEQ, nullptr, 0, tab, wsum, F.tid);
        for (int i = F.wave; i < 16; i += NWAVES) {
            const int tb = 2 * i + half, t = tb * 64 + lane; const size_t row = (size_t)b * SEQ + t;
            float q[64], o[64];
#pragma unroll
            for (int d = 0; d < 64; d += 8) { float f[8]; unpack8(*(const GAS v4u*)(Qb + row * D + h * HD + d), f);
#pragma unroll
                for (int j = 0; j < 8; ++j) { q[d + j] = f[j]; o[d + j] = 0.f; } }
            float mx = -1e30f, l = 0.f;
            const int kend = tb * 64 + 63;
            for (int k = 0; k <= kend; ++k) {
                const size_t kr = ((size_t)b * SEQ + k) * D + h * HD;
                float s = 0.f;
#pragma unroll
                for (int d = 0; d < 64; d += 8) { float f[8]; unpack8(*(const GAS v4u*)(Kb + kr + d), f);
#pragma unroll
                    for (int j = 0; j < 8; ++j) s += q[d + j] * f[j]; }
                s += tab[k];
                if (k > t) s = -1e30f;
                const float mn = fmaxf(mx, s), al = __builtin_amdgcn_exp2f(mx - mn), p = (k > t) ? 0.f : __builtin_amdgcn_exp2f(s - mn);
                mx = mn; l = l * al + p;
#pragma unroll
                for (int d = 0; d < 64; d += 8) { float f[8]; unpack8(*(const GAS v4u*)(Vb + kr + d), f);
#pragma unroll
                    for (int j = 0; j < 8; ++j) o[d + j] = o[d + j] * al + p * f[j]; }
            }
            const float il = 1.0f / l;
#pragma unroll
            for (int d = 0; d < 64; d += 8) { v4u w; w.x = pk2(o[d] * il, o[d + 1] * il); w.y = pk2(o[d + 2] * il, o[d + 3] * il); w.z = pk2(o[d + 4] * il, o[d + 5] * il); w.w = pk2(o[d + 6] * il, o[d + 7] * il);
                *(GAS v4u*)(Qb + row * D + h * HD + d) = w; }
        }
        if (half == 0) {
            __syncthreads();
            cumsum_table(F.cache_lf + (size_t)b * PAST * NH + h, PAST, F.out + O_LFS + (size_t)b * DSEQ * NH + h, DSEQ, tab, wsum, F.tid);
            if (F.wave == 0) {
                const int t = lane; const size_t row = (size_t)MP + (size_t)b * DSEQ + t;
                float q[64], o[64];
#pragma unroll
                for (int d = 0; d < 64; d += 8) { float f[8]; unpack8(*(const GAS v4u*)(Qb + row * D + h * HD + d), f);
#pragma unroll
                    for (int j = 0; j < 8; ++j) { q[d + j] = f[j]; o[d + j] = 0.f; } }
                float mx = -1e30f, l = 0.f;
                for (int k = 0; k < PAST; ++k) {
                    const float* kp = F.cache_k + (((size_t)b * PAST + k) * NH + h) * HD; const float* vp = F.cache_v + (((size_t)b * PAST + k) * NH + h) * HD;
                    float s = 0.f;
#pragma unroll
                    for (int d = 0; d < 64; d += 4) { const pg8::f32x4 f = *(const GAS pg8::f32x4*)(kp + d); s += q[d] * f[0] + q[d + 1] * f[1] + q[d + 2] * f[2] + q[d + 3] * f[3]; }
                    s += tab[k];
                    const float mn = fmaxf(mx, s), al = __builtin_amdgcn_exp2f(mx - mn), p = __builtin_amdgcn_exp2f(s - mn);
                    mx = mn; l = l * al + p;
#pragma unroll
                    for (int d = 0; d < 64; d += 4) { const pg8::f32x4 f = *(const GAS pg8::f32x4*)(vp + d); o[d] = o[d] * al + p * f[0]; o[d + 1] = o[d + 1] * al + p * f[1]; o[d + 2] = o[d + 2] * al + p * f[2]; o[d + 3] = o[d + 3] * al + p * f[3]; }
                }
                for (int k = 0; k < DSEQ; ++k) {
                    const size_t kr = ((size_t)MP + (size_t)b * DSEQ + k) * D + h * HD;
                    float s = 0.f;
#pragma unroll
                    for (int d = 0; d < 64; d += 8) { float f[8]; unpack8(*(const GAS v4u*)(Kb + kr + d), f);
#pragma unroll
                        for (int j = 0; j < 8; ++j) s += q[d + j] * f[j]; }
                    s += tab[PAST + k];
                    if (k > t) s = -1e30f;
                    const float mn = fmaxf(mx, s), al = __builtin_amdgcn_exp2f(mx - mn), p = (k > t) ? 0.f : __builtin_amdgcn_exp2f(s - mn);
                    mx = mn; l = l * al + p;
#pragma unroll
                    for (int d = 0; d < 64; d += 8) { float f[8]; unpack8(*(const GAS v4u*)(Vb + kr + d), f);
#pragma unroll
                        for (int j = 0; j < 8; ++j) o[d + j] = o[d + j] * al + p * f[j]; }
                }
                const float il = 1.0f / l;
#pragma unroll
                for (int d = 0; d < 64; d += 8) { v4u w; w.x = pk2(o[d] * il, o[d + 1] * il); w.y = pk2(o[d + 2] * il, o[d + 3] * il); w.z = pk2(o[d + 4] * il, o[d + 5] * il); w.w = pk2(o[d + 6] * il, o[d + 7] * il);
                    *(GAS v4u*)(Qb + row * D + h * HD + d) = w; }
            }
        }
    }
    __syncthreads();
}

template <class Epi, class Sched>
__device__ __forceinline__ void run_gemm(Frame& F, const pg8::Gemm& g, const Sched& S, const Epi& E) {
#if MK_FAST_GEMM
    pg8::gemm_phase<Epi, Sched, Epi::AFTER_DRAIN ? false : PG8_ALIGN, PG8_SP2>(F.lds + RING_OFF, g, S, E);
#else
    mk::gemm_phase_simple<Epi, Sched>(F.lds + RING_OFF, g, S, E);
#endif
}
__device__ __forceinline__ void out_proj_phase(Frame& F, const bf16* A, const bf16* Bt, int K, const float* base_p, const float* base_s, float scale) {
    float* X = F.out + O_Y;
    pg8::Gemm g{A, Bt, M, D, K};
    mk::EpiRes E{base_p, base_s, X, ws_bf(F, WS_XB), (float*)(F.ws + WS_RS), scale};
    const int nunits = (M / 256) * (D / 256);
    for (int rnd = 0; rnd * F.G < nunits; ++rnd) {
        mk::RoundOrder S; S.init(M, D, F.G, (int)blockIdx.x); S.rnd = rnd;
        run_gemm(F, g, S, E);
        __syncthreads();
    }
}
__device__ __forceinline__ void ffn_in_phase(Frame& F, int w) {
    pg8::Gemm g{ws_bf(F, WS_XB), ws_bf(F, WS_FFI + (size_t)w * SZ_FFI), M, 2 * FF, D};
    pg8::StaticOrder S; S.init(M, 2 * FF, F.G, (int)blockIdx.x);
    mk::EpiSwiglu E{ws_bf(F, WS_H), (const float*)(F.ws + WS_RS)};
    run_gemm(F, g, S, E);
}

struct Args { const float* in[18]; float* out; unsigned char* ws; int ph_lo, ph_hi; };
__global__ void __launch_bounds__(NWAVES * 64, 2) mk_fwd(Args args) {
    extern __shared__ __attribute__((aligned(16))) unsigned char lds[];
    Frame F;
    F.lds = (LAS unsigned char*)lds;
    F.MISC = (volatile LAS unsigned*)(F.lds + MISC_OFF);
    F.tid = threadIdx.x; F.lane = F.tid & 63; F.wave = __builtin_amdgcn_readfirstlane(F.tid >> 6);
    F.G = gridDim.x; { const int bx = blockIdx.x; F.vcu = (F.G % 8 == 0) ? (bx % 8) * (F.G / 8) + bx / 8 : bx; }
    F.ws = args.ws; F.out = args.out; F.ctl = (gu32*)(args.ws + WS_CTL);
    F.x_p = args.in[0]; F.x_s = args.in[1]; F.state_conv = args.in[2]; F.cache_k = args.in[3]; F.cache_v = args.in[4]; F.cache_lf = args.in[5];
    F.norm_ffn = args.in[6]; F.ffn_w_in = args.in[7]; F.ffn_w_out = args.in[8]; F.norm_mix = args.in[9]; F.conv_w_in = args.in[10]; F.conv_w = args.in[11];
    F.conv_w_out = args.in[12]; F.attn_w_in = args.in[13]; F.attn_bf = args.in[14]; F.q_norm = args.in[15]; F.k_norm = args.in[16]; F.attn_w_out = args.in[17];
    for (int u = F.tid; u < (LDS_BYTES - LDSCTL_OFF) / 4; u += NWAVES * 64) ((LAS unsigned*)(F.lds + LDSCTL_OFF))[u] = 0u;
    __syncthreads();
#if MK_ONE_LAUNCH
    XcdBarrier bar = xcd_barrier_post((unsigned*)(F.ctl + CW_BAR), F.MISC + 8);
#define GRID_BAR() xcd_barrier(bar)
#else
#define GRID_BAR() do {} while (0)
#endif
    const int lo = args.ph_lo, hi = args.ph_hi;
#define IN(k) (lo <= (k) && (k) < hi)
#define SEAM(k) do { if (IN(k) && IN((k) + 1)) GRID_BAR(); } while (0)
    float* X = F.out + O_Y;
    const float* Xs = X + (size_t)MP * D;

    if (IN(0)) { p0_prologue(F); VM_WAIT(); __syncthreads(); } SEAM(0);
    if (IN(1)) ffn_in_phase(F, 0); SEAM(1);
    if (IN(2)) out_proj_phase(F, ws_bf(F, WS_H), ws_bf(F, WS_FFO + 0 * SZ_FFO), FF, F.x_p, F.x_s, 0.5f); SEAM(2);
    if (IN(3)) {
        pg8::Gemm g{ws_bf(F, WS_XB), ws_bf(F, WS_CI), M, 3 * D, D};
        pg8::StaticOrder S; S.init(M, 3 * D, F.G, (int)blockIdx.x);
        mk::EpiConvIn E{ws_bf(F, WS_BIG), ws_bf(F, WS_BIG + SZ_ACT), (const float*)(F.ws + WS_RS), F.out + O_CSP, F.out + O_CSS};
        run_gemm(F, g, S, E);
    } SEAM(3);
    if (IN(4)) conv_ew_phase(F); SEAM(4);
    if (IN(5)) out_proj_phase(F, ws_bf(F, WS_BIG), ws_bf(F, WS_CO), D, X, Xs, 1.0f); SEAM(5);
    if (IN(6)) ffn_in_phase(F, 1); SEAM(6);
    if (IN(7)) out_proj_phase(F, ws_bf(F, WS_H), ws_bf(F, WS_FFO + 1 * SZ_FFO), FF, X, Xs, 0.5f); SEAM(7);
    if (IN(8)) ffn_in_phase(F, 2); SEAM(8);
    if (IN(9)) out_proj_phase(F, ws_bf(F, WS_H), ws_bf(F, WS_FFO + 2 * SZ_FFO), FF, X, Xs, 0.5f); SEAM(9);
    if (IN(10)) {
        pg8::Gemm g{ws_bf(F, WS_XB), ws_bf(F, WS_AI), M, NAI, D};
        pg8::StaticOrder S; S.init(M, NAI, F.G, (int)blockIdx.x);
        mk::EpiAttnIn E{ws_bf(F, WS_BIG), ws_bf(F, WS_BIG + SZ_ACT), ws_bf(F, WS_BIG + 2 * SZ_ACT), (const float*)(F.ws + WS_RS), F.q_norm, F.k_norm, F.attn_bf,
                        F.out + O_KP, F.out + O_KS, F.out + O_VP, F.out + O_VS, F.out + O_LFP, F.out + O_LFS};
        run_gemm(F, g, S, E);
    } SEAM(10);
    if (IN(11)) { attn_simple_phase(F); } SEAM(11);
    if (IN(12)) out_proj_phase(F, ws_bf(F, WS_BIG), ws_bf(F, WS_AO), D, X, Xs, 1.0f); SEAM(12);
    if (IN(13)) ffn_in_phase(F, 3); SEAM(13);
    if (IN(14)) out_proj_phase(F, ws_bf(F, WS_H), ws_bf(F, WS_FFO + 3 * SZ_FFO), FF, X, Xs, 0.5f);
#undef IN
#undef SEAM
}

extern "C" void kernel_launch(void* const* d_in, const int* in_sizes, int n_in, void* d_out, int out_size, void* d_ws, size_t ws_size, hipStream_t stream) {
    static int grid = 0;
    if (grid == 0) {
        if (n_in != 18 || in_sizes[0] != MP * D || (size_t)out_size != O_END || ws_size < WS_END) {
            fprintf(stderr, "kernel_launch: unexpected problem: n_in %d in0 %d out %d ws %zu; nothing launched\n", n_in, n_in > 0 ? in_sizes[0] : -1, out_size, ws_size); grid = -1; return; }
        int dev = 0, cus = 0, per_cu = 0;
        if (hipGetDevice(&dev) != hipSuccess || hipDeviceGetAttribute(&cus, hipDeviceAttributeMultiprocessorCount, dev) != hipSuccess) { grid = -1; return; }
        if (hipFuncSetAttribute((const void*)mk_fwd, hipFuncAttributeMaxDynamicSharedMemorySize, LDS_BYTES) != hipSuccess) { fprintf(stderr, "kernel_launch: hipFuncSetAttribute failed\n"); grid = -1; return; }
        if (hipOccupancyMaxActiveBlocksPerMultiprocessor(&per_cu, (const void*)mk_fwd, NWAVES * 64, LDS_BYTES) != hipSuccess || per_cu < 1)
            fprintf(stderr, "kernel_launch: note: occupancy query reports %d workgroups per CU\n", per_cu);
        (void)hipGetLastError();
        grid = cus;
    }
    if (grid < 0) return;
    if (hipMemsetAsync((char*)d_ws + WS_CTL, 0, CTL_ZERO_BYTES, stream) != hipSuccess) return;
    Args a{};
    for (int i = 0; i < 18; ++i) a.in[i] = (const float*)d_in[i];
    a.out = (float*)d_out; a.ws = (unsigned char*)d_ws;
#if MK_ONE_LAUNCH
    a.ph_lo = 0; a.ph_hi = NPH;
    hipLaunchKernelGGL(mk_fwd, dim3(grid), dim3(NWAVES * 64), LDS_BYTES, stream, a);
#else
    for (int p = 0; p < NPH; ++p) { a.ph_lo = p; a.ph_hi = p + 1; hipLaunchKernelGGL(mk_fwd, dim3(grid), dim3(NWAVES * 64), LDS_BYTES, stream, a); }
#endif
}
```

```cpp
#include <hip/hip_runtime.h>
#include <hip/hip_bf16.h>
#include <cstdio>
#include <cstdint>
#include <cmath>

#ifndef MK_ONE_LAUNCH
#define MK_ONE_LAUNCH 1
#endif
#ifndef MK_FAST_GEMM
#define MK_FAST_GEMM 1
#endif
#ifndef MK_FAST_ATTN
#define MK_FAST_ATTN 1
#endif

constexpr int D = 1024, NH = 16, HD = 64, FF = 2816, SEQ = 2048, NB = 8, DSEQ = 64, PAST = 2048;
constexpr int MP = NB * SEQ, MS = NB * DSEQ, M = MP + MS;
constexpr int NAI = 3328;
constexpr float NORM_EPS = 1e-6f, LOG2E = 1.4426950408889634f;
constexpr float QSCALE = 0.125f * LOG2E;

constexpr size_t O_Y = 0;
constexpr size_t O_CSP = (size_t)M * D;
constexpr size_t O_CSS = O_CSP + (size_t)NB * 2 * D;
constexpr size_t O_KP = O_CSS + (size_t)NB * 2 * D;
constexpr size_t O_VP = O_KP + (size_t)MP * D;
constexpr size_t O_LFP = O_VP + (size_t)MP * D;
constexpr size_t O_KS = O_LFP + (size_t)MP * NH;
constexpr size_t O_VS = O_KS + (size_t)MS * D;
constexpr size_t O_LFS = O_VS + (size_t)MS * D;
constexpr size_t O_END = O_LFS + (size_t)MS * NH;

constexpr size_t MiB = 1u << 20;
constexpr size_t WS_CTL = 0, CTL_ZERO_BYTES = 1 * MiB;
constexpr size_t SZ_FFI = (size_t)2 * FF * D * 2, SZ_FFO = (size_t)D * FF * 2;
constexpr size_t WS_FFI = 1 * MiB;
constexpr size_t WS_FFO = WS_FFI + 4 * SZ_FFI;
constexpr size_t WS_CI = WS_FFO + 4 * SZ_FFO;
constexpr size_t WS_CO = WS_CI + (size_t)3 * D * D * 2;
constexpr size_t WS_AI = WS_CO + (size_t)D * D * 2;
constexpr size_t WS_AO = WS_AI + (size_t)NAI * D * 2;
constexpr size_t WS_XB = WS_AO + (size_t)D * D * 2;
constexpr size_t WS_RS = WS_XB + (size_t)M * D * 2;
constexpr size_t WS_BIG = ((WS_RS + (size_t)M * 16 + MiB - 1) / MiB) * MiB;
constexpr size_t SZ_ACT = (size_t)M * D * 2;
constexpr size_t WS_H = WS_BIG;
constexpr size_t WS_END = WS_BIG + 3 * SZ_ACT;
static_assert(WS_END <= 256 * MiB && (size_t)M * FF * 2 <= 3 * SZ_ACT, "d_ws map");
constexpr int CW_TMO = 0, CW_CODE = 1, CW_BAR = 4096;

constexpr int RING_OFF = 0, RING_BYTES = 131072, LDSCTL_OFF = RING_BYTES, MISC_OFF = LDSCTL_OFF + 320, LDS_BYTES = 147456;
constexpr int NWAVES = 8;
constexpr int NPH = 15;

#define GAS __attribute__((address_space(1)))
#define LAS __attribute__((address_space(3)))
typedef unsigned short bf16;
typedef unsigned v4u __attribute__((ext_vector_type(4)));
typedef unsigned v2u __attribute__((ext_vector_type(2)));
typedef GAS unsigned gu32;
#define RLX_AGENT __ATOMIC_RELAXED, __HIP_MEMORY_SCOPE_AGENT
#define LDS_WAIT() asm volatile("s_waitcnt lgkmcnt(0)" ::: "memory")
#define VM_WAIT() asm volatile("s_waitcnt vmcnt(0)" ::: "memory")
__device__ __forceinline__ unsigned f2bf(float f) { unsigned u = __builtin_bit_cast(unsigned, f); return (u + 0x7fffu + ((u >> 16) & 1u)) >> 16; }
__device__ __forceinline__ unsigned pk2(float lo, float hi) { return f2bf(lo) | (f2bf(hi) << 16); }
__device__ __forceinline__ float bf2f(unsigned short h) { return __builtin_bit_cast(float, (unsigned)h << 16); }
__device__ __forceinline__ float bflo(unsigned w) { return __builtin_bit_cast(float, w << 16); }
__device__ __forceinline__ float bfhi(unsigned w) { return __builtin_bit_cast(float, w & 0xffff0000u); }

namespace pg8 {
#define PG8_LAS __attribute__((address_space(3)))
typedef unsigned short bf16_t;
typedef short bf16x8 __attribute__((ext_vector_type(8)));
typedef float f32x4 __attribute__((ext_vector_type(4)));
typedef unsigned u32x4 __attribute__((ext_vector_type(4)));
constexpr int BM = 256, BK = 64, HALF = 128, HTB = HALF * BK * 2  , STAGE_BYTES = 8 * HTB, NXCD = 8, WGM = 8;

__host__ __device__ __forceinline__ int lds_byte(int r, int c) { const int st = (r >> 4) * 2 + (c >> 5), rr = r & 15, cc = c & 31, ob = rr * 64 + cc * 2; return st * 1024 + (ob ^ (((ob >> 9) & 1) << 5)); }
__host__ __device__ __forceinline__ void stage_rc(int b, int& R, int& C) { const int st = b / 1024, sb = b % 1024, swz = sb ^ (((sb >> 9) & 1) << 5); R = (st >> 1) * 16 + swz / 64; C = (st & 1) * 32 + (swz % 64) / 2; }
__host__ __device__ __forceinline__ int perm32(int rho) { const int n = rho >> 4, i = rho & 15; return 8 * (i >> 2) + 4 * n + (i & 3); }

struct Unit { int pm, pn; };
struct Gemm { const bf16_t* A; const bf16_t* Bt; int M, N, K; };

struct StaticOrder {
    int nM, nN, nwg, G, c;
    __host__ __device__ void init(int M, int N, int G_, int c_) { nM = M / BM; nN = N / BM; nwg = nM * nN; G = G_; c = c_; }
    __host__ __device__ bool next(int i, Unit& u) const {
        const long L = (long)i * G + c; if (L >= nwg) return false;
        int wgid = (int)L; { const int q = nwg / NXCD, r = nwg % NXCD, xcd = wgid % NXCD, off = wgid / NXCD; wgid = (xcd < r ? xcd * (q + 1) : r * (q + 1) + (xcd - r) * q) + off; }
        const int nig = WGM * nN, gid = wgid / nig, fm = gid * WGM, gsz = (nM - fm) < WGM ? (nM - fm) : WGM;
        u.pm = fm + ((wgid % nig) % gsz); u.pn = (wgid % nig) / gsz; return true;
    }
    __device__ __forceinline__ void a_ready(const Unit&) const {}
    __device__ __forceinline__ void done(const Unit&) const {}
};

__device__ __forceinline__ unsigned cvt_pk_bf16(float lo, float hi) { unsigned r; asm volatile("v_cvt_pk_bf16_f32 %0, %1, %2" : "=v"(r) : "v"(lo), "v"(hi)); return r; }
template <class Epi, class Sched, bool ALIGN_EPI = false, bool SP2 = false>
__device__ __forceinline__ void gemm_phase(PG8_LAS unsigned char* lds, const Gemm g, const Sched& S, const Epi& E) {
    const int tid = threadIdx.x, wid = __builtin_amdgcn_readfirstlane(tid >> 6), lane = tid & 63, wr = wid >> 2, wc = wid & 3, fr = lane & 15, fq = lane >> 4;
    const int K = g.K, nt = K / BK;
    unsigned voffA[2], voffB[2];
#pragma unroll
    for (int i = 0; i < 2; ++i) { int R, C; stage_rc(tid * 16 + i * 8192, R, C); const int Rb = Epi::PERM ? ((R & ~31) + perm32(R & 31)) : R;
        voffA[i] = (unsigned)(R * K + C) * 2u; voffB[i] = (unsigned)(Rb * K + C) * 2u; }
    const size_t kstep = (size_t)(BK * 2);
    const size_t hstep = (size_t)HALF * K * 2;
    const size_t tstep = 2 * hstep;
    const unsigned ldsw = (unsigned)wid * 1024u;
    const int aoff = lds_byte(wr * 64 + fr, fq * 8), boff = lds_byte(wc * 32 + fr, fq * 8);
#define PG8_SA(b, h) (((b) * 2 + (h)) * HTB)
#define PG8_SB(b, h) ((4 + (b) * 2 + (h)) * HTB)
#define PG8_STAGE(bufoff, gbase, voff) do { _Pragma("unroll") for (int _i = 0; _i < 2; ++_i) \
        __builtin_amdgcn_global_load_lds((const unsigned*)((const char*)(gbase) + (voff)[_i]), (PG8_LAS unsigned*)(lds + (bufoff) + ldsw + _i * 8192), 16, 0, 0); } while (0)
#define PG8_LDA(dst, b, h) do { _Pragma("unroll") for (int m = 0; m < 4; ++m) _Pragma("unroll") for (int k = 0; k < 2; ++k) dst[m][k] = *(const PG8_LAS bf16x8*)(lds + PG8_SA(b, h) + aoff + m * 2048 + k * 1024); } while (0)
#define PG8_LDB(dst, b, h) do { _Pragma("unroll") for (int n = 0; n < 2; ++n) _Pragma("unroll") for (int k = 0; k < 2; ++k) dst[n][k] = *(const PG8_LAS bf16x8*)(lds + PG8_SB(b, h) + boff + n * 2048 + k * 1024); } while (0)
#define PG8_MMA(ai, bj, At, Bt) do { __builtin_amdgcn_s_setprio(1); _Pragma("unroll") for (int m = 0; m < 4; ++m) _Pragma("unroll") for (int n = 0; n < 2; ++n) _Pragma("unroll") for (int k = 0; k < 2; ++k) \
        acc[ai][bj][m][n] = __builtin_amdgcn_mfma_f32_16x16x32_bf16(Bt[n][k], At[m][k], acc[ai][bj][m][n], 0, 0, 0); __builtin_amdgcn_s_setprio(0); } while (0)
#define PG8_WAIT_V(n) asm volatile("s_waitcnt vmcnt(" #n ")" ::: "memory")
#define PG8_WAIT_L(n) asm volatile("s_waitcnt lgkmcnt(" #n ")" ::: "memory")
#define PG8_BAR __builtin_amdgcn_s_barrier()
#define PG8_SCHED __builtin_amdgcn_sched_barrier(0)
    Unit cur, nxt; int ui = 0;
    if (!S.next(0, cur)) return;
    f32x4 acc[2][2][4][2];
#pragma unroll
    for (int a = 0; a < 2; ++a)
#pragma unroll
        for (int b = 0; b < 2; ++b)
#pragma unroll
            for (int m = 0; m < 4; ++m)
#pragma unroll
                for (int n = 0; n < 2; ++n) acc[a][b][m][n] = (f32x4){0.f, 0.f, 0.f, 0.f};
    bf16x8 At[4][2], B0[2][2], B1[2][2];
    const char* cA = (const char*)g.A + (size_t)cur.pm * tstep; const char* cB = (const char*)g.Bt + (size_t)cur.pn * tstep;
    S.a_ready(cur);
    if constexpr (SP2) {
        PG8_STAGE(PG8_SB(0, 0), cB, voffB); PG8_STAGE(PG8_SB(0, 1), cB + hstep, voffB); PG8_STAGE(PG8_SA(0, 0), cA, voffA); PG8_STAGE(PG8_SA(0, 1), cA + hstep, voffA);
        if (wr == 1) PG8_BAR;
        PG8_WAIT_V(2); PG8_BAR;
        PG8_STAGE(PG8_SB(1, 0), cB + kstep, voffB); PG8_STAGE(PG8_SA(1, 0), cA + kstep, voffA); PG8_STAGE(PG8_SB(1, 1), cB + hstep + kstep, voffB);
        PG8_WAIT_V(6); PG8_BAR;
    } else {
        PG8_STAGE(PG8_SB(0, 0), cB, voffB); PG8_STAGE(PG8_SA(0, 0), cA, voffA); PG8_STAGE(PG8_SB(0, 1), cB + hstep, voffB); PG8_STAGE(PG8_SA(0, 1), cA + hstep, voffA);
        if (wr == 1) PG8_BAR;
        PG8_WAIT_V(4); PG8_BAR;
        PG8_STAGE(PG8_SB(1, 0), cB + kstep, voffB); PG8_STAGE(PG8_SA(1, 0), cA + kstep, voffA); PG8_STAGE(PG8_SB(1, 1), cB + hstep + kstep, voffB);
        PG8_WAIT_V(6); PG8_BAR;
    }
    for (;;) {
        const bool has_next = S.next(ui + 1, nxt);
        const char* nA = has_next ? (const char*)g.A + (size_t)nxt.pm * tstep : cA; const char* nB = has_next ? (const char*)g.Bt + (size_t)nxt.pn * tstep : cB;
        for (int t = 0; t < nt; t += 2) {
            const bool last = (t == nt - 2);
            const char* a1 = cA + (size_t)(t + 1) * kstep;
            const char* a2 = last ? nA : cA + (size_t)(t + 2) * kstep; const char* b2 = last ? nB : cB + (size_t)(t + 2) * kstep;
            const char* a3 = a2 + kstep; const char* b3 = b2 + kstep;
            if (last && has_next) S.a_ready(nxt);
            if constexpr (SP2) {
            PG8_LDB(B0, 0, 0); PG8_LDB(B1, 0, 1); PG8_SCHED; PG8_LDA(At, 0, 0); PG8_STAGE(PG8_SA(1, 1), a1 + hstep, voffA);
            PG8_WAIT_V(8); PG8_WAIT_L(0); PG8_BAR; PG8_MMA(0, 0, At, B0); PG8_MMA(0, 1, At, B1); PG8_BAR; PG8_SCHED;
            PG8_LDA(At, 0, 1); PG8_STAGE(PG8_SB(0, 0), b2, voffB); PG8_STAGE(PG8_SB(0, 1), b2 + hstep, voffB); PG8_STAGE(PG8_SA(0, 0), a2, voffA);
            PG8_WAIT_V(8); PG8_WAIT_L(0); PG8_BAR; PG8_MMA(1, 0, At, B0); PG8_MMA(1, 1, At, B1); PG8_BAR; PG8_SCHED;
            PG8_LDB(B0, 1, 0); PG8_LDB(B1, 1, 1); PG8_SCHED; PG8_LDA(At, 1, 0); PG8_STAGE(PG8_SA(0, 1), a2 + hstep, voffA);
            PG8_WAIT_V(8); PG8_WAIT_L(0); PG8_BAR; PG8_MMA(0, 0, At, B0); PG8_MMA(0, 1, At, B1); PG8_BAR; PG8_SCHED;
            PG8_LDA(At, 1, 1); PG8_STAGE(PG8_SB(1, 0), b3, voffB); PG8_STAGE(PG8_SB(1, 1), b3 + hstep, voffB); PG8_STAGE(PG8_SA(1, 0), a3, voffA);
            PG8_WAIT_V(8); PG8_WAIT_L(0); PG8_BAR; PG8_MMA(1, 0, At, B0); PG8_MMA(1, 1, At, B1); PG8_BAR; PG8_SCHED;
            } else {
            PG8_LDB(B0, 0, 0); PG8_SCHED; PG8_LDA(At, 0, 0); PG8_STAGE(PG8_SA(1, 1), a1 + hstep, voffA);
            PG8_WAIT_L(8); PG8_BAR; PG8_WAIT_L(0); PG8_MMA(0, 0, At, B0); PG8_BAR; PG8_SCHED;
            PG8_LDB(B1, 0, 1); PG8_STAGE(PG8_SB(0, 0), b2, voffB);
            PG8_BAR; PG8_WAIT_L(0); PG8_MMA(0, 1, At, B1); PG8_BAR;
            PG8_LDA(At, 0, 1); PG8_STAGE(PG8_SA(0, 0), a2, voffA);
            PG8_BAR; PG8_WAIT_L(0); PG8_MMA(1, 0, At, B0); PG8_BAR; PG8_SCHED;
            PG8_STAGE(PG8_SB(0, 1), b2 + hstep, voffB);
            PG8_WAIT_V(6); PG8_BAR; PG8_MMA(1, 1, At, B1); PG8_BAR;
            PG8_LDB(B0, 1, 0); PG8_SCHED; PG8_LDA(At, 1, 0); PG8_STAGE(PG8_SA(0, 1), a2 + hstep, voffA);
            PG8_WAIT_L(8); PG8_BAR; PG8_WAIT_L(0); PG8_MMA(0, 0, At, B0); PG8_BAR; PG8_SCHED;
            PG8_LDB(B1, 1, 1); PG8_STAGE(PG8_SB(1, 0), b3, voffB);
            PG8_BAR; PG8_WAIT_L(0); PG8_MMA(0, 1, At, B1); PG8_BAR;
            PG8_LDA(At, 1, 1); PG8_STAGE(PG8_SA(1, 0), a3, voffA);
            PG8_BAR; PG8_WAIT_L(0); PG8_MMA(1, 0, At, B0); PG8_BAR; PG8_SCHED;
            PG8_STAGE(PG8_SB(1, 1), b3 + hstep, voffB);
            PG8_WAIT_V(6); PG8_BAR; PG8_MMA(1, 1, At, B1); PG8_BAR;
            }
        }
        if constexpr (ALIGN_EPI) { if (wr == 0) PG8_BAR; }
        if constexpr (!Epi::AFTER_DRAIN) { E(acc, cur, wr, wc, fr, fq); S.done(cur); }
        if (!has_next) break;
#pragma unroll
        for (int a = 0; a < 2; ++a)
#pragma unroll
            for (int b = 0; b < 2; ++b)
#pragma unroll
                for (int m = 0; m < 4; ++m)
#pragma unroll
                    for (int n = 0; n < 2; ++n) acc[a][b][m][n] = (f32x4){0.f, 0.f, 0.f, 0.f};
        cur = nxt; cA = nA; cB = nB; ++ui;
        if constexpr (ALIGN_EPI) { if (wr == 1) PG8_BAR; }
    }
    PG8_WAIT_V(0);
    if constexpr (!ALIGN_EPI) { if (wr == 0) PG8_BAR; }
    PG8_BAR;
    if constexpr (Epi::AFTER_DRAIN) { E.fused(acc, cur, wr, wc, fr, fq, lds, wid, lane); S.done(cur); }
#undef PG8_SA
#undef PG8_SB
#undef PG8_STAGE
#undef PG8_LDA
#undef PG8_LDB
#undef PG8_MMA
#undef PG8_WAIT_V
#undef PG8_WAIT_L
#undef PG8_BAR
#undef PG8_SCHED
}
}

#ifndef PG8_SP2
#define PG8_SP2 true
#endif
#ifndef PG8_ALIGN
#define PG8_ALIGN true
#endif

namespace mk {
using pg8::f32x4; using pg8::bf16x8; using pg8::u32x4; using pg8::Unit; using pg8::Gemm; using pg8::bf16_t; using pg8::cvt_pk_bf16; using pg8::perm32;
typedef unsigned u32x2 __attribute__((ext_vector_type(2)));
constexpr int BM = 256, HALF = 128;

__device__ __forceinline__ float row_rstd(const float* RS, int row) {
    const f32x4 p = *(const f32x4*)(RS + (size_t)row * 4);
    return rsqrtf(((p[0] + p[1]) + (p[2] + p[3])) * (1.0f / D) + NORM_EPS);
}
__device__ __forceinline__ float silu_mul(float g, float u) {
    const float e = __builtin_amdgcn_exp2f(-g * LOG2E);
    return g * u * __builtin_amdgcn_rcpf(1.0f + e);
}
__device__ __forceinline__ float log_sigmoid(float x) { return fminf(x, 0.f) - log1pf(__expf(-fabsf(x))); }

struct RoundOrder : pg8::StaticOrder {
    int rnd;
    __device__ __forceinline__ bool next(int i, Unit& u) const { if (i > 0) return false; return pg8::StaticOrder::next(rnd, u); }
};

struct EpiSwiglu {
    static constexpr bool PERM = true, AFTER_DRAIN = false;
    bf16_t* Hout; const float* RS;
    __device__ __forceinline__ void operator()(const f32x4 (&acc)[2][2][4][2], const Unit& u, int wr, int wc, int fr, int fq) const {
        const int row0 = u.pm * BM + wr * 64 + fr, col0 = u.pn * HALF + wc * 32 + 8 * fq;
#pragma unroll
        for (int ai = 0; ai < 2; ++ai)
#pragma unroll
            for (int m = 0; m < 4; ++m) {
                const int row = row0 + ai * HALF + m * 16; const float r = row_rstd(RS, row);
                const f32x4 g0 = acc[ai][0][m][0] * r, g1 = acc[ai][0][m][1] * r, u0 = acc[ai][1][m][0] * r, u1 = acc[ai][1][m][1] * r;
                u32x4 w;
                w.x = cvt_pk_bf16(silu_mul(g0[0], u0[0]), silu_mul(g0[1], u0[1])); w.y = cvt_pk_bf16(silu_mul(g0[2], u0[2]), silu_mul(g0[3], u0[3]));
                w.z = cvt_pk_bf16(silu_mul(g1[0], u1[0]), silu_mul(g1[1], u1[1])); w.w = cvt_pk_bf16(silu_mul(g1[2], u1[2]), silu_mul(g1[3], u1[3]));
                *(u32x4*)(Hout + (size_t)row * FF + col0) = w;
            }
    }
};

struct EpiRes {
    static constexpr bool PERM = false, AFTER_DRAIN = true;
    const float* base_p; const float* base_s; float* X; bf16_t* XB; float* RS; float scale;
    __device__ __forceinline__ void fused(f32x4 (&acc)[2][2][4][2], const Unit& u, int wr, int wc, int fr, int fq, PG8_LAS unsigned char* lds, int wid, int lane) const {
        PG8_LAS float* P = (PG8_LAS float*)lds;
        const int col0 = u.pn * BM + wc * 32 + 4 * fq;
#pragma unroll
        for (int ai = 0; ai < 2; ++ai)
#pragma unroll
            for (int m = 0; m < 4; ++m) {
                const int rl = ai * HALF + wr * 64 + m * 16 + fr, row = u.pm * BM + rl;
                const float* bp = row < MP ? base_p + (size_t)row * D : base_s + (size_t)(row - MP) * D;
                float ss = 0.f;
#pragma unroll
                for (int bj = 0; bj < 2; ++bj)
#pragma unroll
                    for (int n = 0; n < 2; ++n) {
                        const int c = col0 + bj * HALF + n * 16;
                        const f32x4 b = *(const f32x4*)(bp + c); const f32x4 v = b + acc[ai][bj][m][n] * scale;
                        *(f32x4*)(X + (size_t)row * D + c) = v;
                        u32x2 w; w.x = cvt_pk_bf16(v[0], v[1]); w.y = cvt_pk_bf16(v[2], v[3]);
                        *(u32x2*)(XB + (size_t)row * D + c) = w;
                        ss += (v[0] * v[0] + v[1] * v[1]) + (v[2] * v[2] + v[3] * v[3]);
                    }
                ss += __shfl_xor(ss, 16); ss += __shfl_xor(ss, 32);
                if (fq == 0) P[rl * 4 + wc] = ss;
                if (m & 1) asm volatile("" ::: "memory");
            }
        asm volatile("s_waitcnt lgkmcnt(0)" ::: "memory"); __builtin_amdgcn_s_barrier(); asm volatile("" ::: "memory");
        const int t = wid * 64 + lane;
        if (t < 256) { const f32x4 p = *(const PG8_LAS f32x4*)(P + t * 4); RS[(size_t)(u.pm * BM + t) * 4 + u.pn] = (p[0] + p[1]) + (p[2] + p[3]); }
        asm volatile("s_waitcnt lgkmcnt(0)" ::: "memory"); __builtin_amdgcn_s_barrier(); asm volatile("" ::: "memory");
    }
};

struct EpiConvIn {
    static constexpr bool PERM = true, AFTER_DRAIN = false;
    bf16_t* G; bf16_t* U; const float* RS; float* cs_p; float* cs_s;
    __device__ __forceinline__ void operator()(const f32x4 (&acc)[2][2][4][2], const Unit& u, int wr, int wc, int fr, int fq) const {
        const int row0 = u.pm * BM + wr * 64 + fr;
        if (u.pn < 4) {
            const int col0 = u.pn * BM + wc * 32 + 8 * fq;
#pragma unroll
            for (int ai = 0; ai < 2; ++ai)
#pragma unroll
                for (int m = 0; m < 4; ++m) {
                    const int row = row0 + ai * HALF + m * 16; const float r = row_rstd(RS, row);
#pragma unroll
                    for (int bj = 0; bj < 2; ++bj) { const f32x4 v0 = acc[ai][bj][m][0] * r, v1 = acc[ai][bj][m][1] * r;
                        u32x4 w; w.x = cvt_pk_bf16(v0[0], v0[1]); w.y = cvt_pk_bf16(v0[2], v0[3]); w.z = cvt_pk_bf16(v1[0], v1[1]); w.w = cvt_pk_bf16(v1[2], v1[3]);
                        *(u32x4*)(G + (size_t)row * D + col0 + bj * HALF) = w; }
                }
        } else {
            const int col0 = (u.pn - 4) * HALF + wc * 32 + 8 * fq;
#pragma unroll
            for (int ai = 0; ai < 2; ++ai)
#pragma unroll
                for (int m = 0; m < 4; ++m) {
                    const int row = row0 + ai * HALF + m * 16; const float r = row_rstd(RS, row), r2 = r * r;
                    const f32x4 v0 = acc[ai][0][m][0] * acc[ai][1][m][0] * r2, v1 = acc[ai][0][m][1] * acc[ai][1][m][1] * r2;
                    u32x4 w; w.x = cvt_pk_bf16(v0[0], v0[1]); w.y = cvt_pk_bf16(v0[2], v0[3]); w.z = cvt_pk_bf16(v1[0], v1[1]); w.w = cvt_pk_bf16(v1[2], v1[3]);
                    *(u32x4*)(U + (size_t)row * D + col0) = w;
                    float* cs = nullptr;
                    if (row < MP) { const int t = row & (SEQ - 1); if (t >= SEQ - 2) cs = cs_p + ((size_t)(row >> 11) * 2 + (t - (SEQ - 2))) * D; }
                    else { const int rr = row - MP, t = rr & (DSEQ - 1); if (t >= DSEQ - 2) cs = cs_s + ((size_t)(rr >> 6) * 2 + (t - (DSEQ - 2))) * D; }
                    if (cs) { *(f32x4*)(cs + col0) = v0; *(f32x4*)(cs + col0 + 4) = v1; }
                }
        }
    }
};

struct EpiAttnIn {
    static constexpr bool PERM = true, AFTER_DRAIN = false;
    bf16_t *Qb, *Kb, *Vb; const float* RS; const float *gq, *gk, *bfg; float *k_p, *k_s, *v_p, *v_s, *lf_p, *lf_s;
    __device__ __forceinline__ void operator()(const f32x4 (&acc)[2][2][4][2], const Unit& u, int wr, int wc, int fr, int fq) const {
        const int row0 = u.pm * BM + wr * 64 + fr, pn = u.pn;
        if (pn < 8) {
            const bool isq = pn < 4; const float* gg = isq ? gq : gk;
            f32x4 gv[2][2];
#pragma unroll
            for (int bj = 0; bj < 2; ++bj)
#pragma unroll
                for (int n = 0; n < 2; ++n) gv[bj][n] = *(const f32x4*)(gg + 32 * bj + 8 * fq + 4 * n);
            const int hcol = ((pn & 3) * 4 + wc) * HD + 8 * fq;
#pragma unroll
            for (int ai = 0; ai < 2; ++ai)
#pragma unroll
                for (int m = 0; m < 4; ++m) {
                    const int row = row0 + ai * HALF + m * 16; const float r = row_rstd(RS, row);
                    float ss = 0.f;
#pragma unroll
                    for (int bj = 0; bj < 2; ++bj)
#pragma unroll
                        for (int n = 0; n < 2; ++n) { const f32x4 a = acc[ai][bj][m][n]; ss += (a[0] * a[0] + a[1] * a[1]) + (a[2] * a[2] + a[3] * a[3]); }
                    ss += __shfl_xor(ss, 16); ss += __shfl_xor(ss, 32);
                    const float f = r * rsqrtf(r * r * ss * (1.0f / HD) + NORM_EPS);
                    float* ko = nullptr; if (!isq) ko = (row < MP ? k_p + (size_t)row * D : k_s + (size_t)(row - MP) * D) + hcol;
#pragma unroll
                    for (int bj = 0; bj < 2; ++bj) {
                        const f32x4 o0 = acc[ai][bj][m][0] * f * gv[bj][0], o1 = acc[ai][bj][m][1] * f * gv[bj][1];
                        if (isq) { const f32x4 s0 = o0 * QSCALE, s1 = o1 * QSCALE;
                            u32x4 w; w.x = cvt_pk_bf16(s0[0], s0[1]); w.y = cvt_pk_bf16(s0[2], s0[3]); w.z = cvt_pk_bf16(s1[0], s1[1]); w.w = cvt_pk_bf16(s1[2], s1[3]);
                            *(u32x4*)(Qb + (size_t)row * D + hcol + 32 * bj) = w; }
                        else { u32x4 w; w.x = cvt_pk_bf16(o0[0], o0[1]); w.y = cvt_pk_bf16(o0[2], o0[3]); w.z = cvt_pk_bf16(o1[0], o1[1]); w.w = cvt_pk_bf16(o1[2], o1[3]);
                            *(u32x4*)(Kb + (size_t)row * D + hcol + 32 * bj) = w;
                            *(f32x4*)(ko + 32 * bj) = o0; *(f32x4*)(ko + 32 * bj + 4) = o1; }
                    }
                }
        } else if (pn < 12) {
            const int col0 = (pn - 8) * BM + wc * 32 + 8 * fq;
#pragma unroll
            for (int ai = 0; ai < 2; ++ai)
#pragma unroll
                for (int m = 0; m < 4; ++m) {
                    const int row = row0 + ai * HALF + m * 16; const float r = row_rstd(RS, row);
                    float* vo = (row < MP ? v_p + (size_t)row * D : v_s + (size_t)(row - MP) * D) + col0;
#pragma unroll
                    for (int bj = 0; bj < 2; ++bj) { const f32x4 o0 = acc[ai][bj][m][0] * r, o1 = acc[ai][bj][m][1] * r;
                        u32x4 w; w.x = cvt_pk_bf16(o0[0], o0[1]); w.y = cvt_pk_bf16(o0[2], o0[3]); w.z = cvt_pk_bf16(o1[0], o1[1]); w.w = cvt_pk_bf16(o1[2], o1[3]);
                        *(u32x4*)(Vb + (size_t)row * D + col0 + bj * HALF) = w;
                        *(f32x4*)(vo + bj * HALF) = o0; *(f32x4*)(vo + bj * HALF + 4) = o1; }
                }
        } else {
            if (wc == 0 && fq < 2) {
                const f32x4 b0 = *(const f32x4*)(bfg + 8 * fq), b1 = *(const f32x4*)(bfg + 8 * fq + 4);
#pragma unroll
                for (int ai = 0; ai < 2; ++ai)
#pragma unroll
                    for (int m = 0; m < 4; ++m) {
                        const int row = row0 + ai * HALF + m * 16; const float r = row_rstd(RS, row);
                        float* lo = (row < MP ? lf_p + (size_t)row * NH : lf_s + (size_t)(row - MP) * NH) + 8 * fq;
                        const f32x4 a0 = acc[ai][0][m][0] * r + b0, a1 = acc[ai][0][m][1] * r + b1;
                        f32x4 l0, l1;
#pragma unroll
                        for (int j = 0; j < 4; ++j) { l0[j] = log_sigmoid(a0[j]); l1[j] = log_sigmoid(a1[j]); }
                        *(f32x4*)lo = l0; *(f32x4*)(lo + 4) = l1;
                    }
            }
        }
    }
};

template <class Epi, class Sched>
__device__ __forceinline__ void gemm_phase_simple(PG8_LAS unsigned char* lds, const Gemm g, const Sched& S, const Epi& E) {
    const int tid = threadIdx.x, wid = __builtin_amdgcn_readfirstlane(tid >> 6), lane = tid & 63, wr = wid >> 2, wc = wid & 3, fr = lane & 15, fq = lane >> 4;
    const int K = g.K;
    Unit cur;
    for (int ui = 0; S.next(ui, cur); ++ui) {
        f32x4 acc[2][2][4][2];
#pragma unroll
        for (int a = 0; a < 2; ++a)
#pragma unroll
            for (int b = 0; b < 2; ++b)
#pragma unroll
                for (int m = 0; m < 4; ++m)
#pragma unroll
                    for (int n = 0; n < 2; ++n) acc[a][b][m][n] = (f32x4){0.f, 0.f, 0.f, 0.f};
        const bf16_t* Ab = g.A + (size_t)(cur.pm * BM + wr * 64 + fr) * K + fq * 8;
        const bf16_t* Bb = g.Bt + (size_t)(cur.pn * BM + wc * 32) * K + fq * 8;
        const int br0 = Epi::PERM ? perm32(fr) : fr, br1 = Epi::PERM ? perm32(16 + fr) : 16 + fr;
        for (int kt = 0; kt < K; kt += 32) {
            bf16x8 a[2][4], b[2][2];
#pragma unroll
            for (int ai = 0; ai < 2; ++ai)
#pragma unroll
                for (int m = 0; m < 4; ++m) a[ai][m] = *(const bf16x8*)(Ab + (size_t)(ai * HALF + m * 16) * K + kt);
#pragma unroll
            for (int bj = 0; bj < 2; ++bj) { b[bj][0] = *(const bf16x8*)(Bb + (size_t)(bj * HALF + br0) * K + kt); b[bj][1] = *(const bf16x8*)(Bb + (size_t)(bj * HALF + br1) * K + kt); }
#pragma unroll
            for (int ai = 0; ai < 2; ++ai)
#pragma unroll
                for (int bj = 0; bj < 2; ++bj)
#pragma unroll
                    for (int m = 0; m < 4; ++m)
#pragma unroll
                        for (int n = 0; n < 2; ++n) acc[ai][bj][m][n] = __builtin_amdgcn_mfma_f32_16x16x32_bf16(b[bj][n], a[ai][m], acc[ai][bj][m][n], 0, 0, 0);
        }
        if constexpr (Epi::AFTER_DRAIN) { __syncthreads(); E.fused(acc, cur, wr, wc, fr, fq, lds, wid, lane); __syncthreads(); }
        else E(acc, cur, wr, wc, fr, fq);
    }
}
}
#include <hip/hip_bf16.h>
#include <cmath>
namespace attn_body {
using bf16=__hip_bfloat16;
using bf16x8=__attribute__((ext_vector_type(8)))short;
using s16x4=__attribute__((ext_vector_type(4)))short;
using f32x16=__attribute__((ext_vector_type(16)))float;
using u32x4=__attribute__((ext_vector_type(4)))unsigned;
constexpr int BATCH=8,NHEAD=16,SEQ=2048,D=64,DM=NHEAD*D;
constexpr int NW=8,QBLK=32,QB=QBLK*NW,KVBLK=64,NQB=SEQ/QB;
constexpr int ATTN_PITCH=DM, ATTN_UNIT_ROWS=QB;
__device__ __forceinline__ int crow(int r,int hi){return (r&3)+8*(r>>2)+4*hi;}
#define SBAR() __builtin_amdgcn_sched_barrier(0)
__device__ __forceinline__ void cmask(f32x16&p0,f32x16&p1,int jb,int qrel,int hi){
  const float NEG=-INFINITY; int kb=64*jb+4*hi;
  #pragma unroll
  for(int r=0;r<16;++r){int kv=kb+(r&3)+8*(r>>2); if(kv>qrel)p0[r]=NEG; if(kv+32>qrel)p1[r]=NEG;}
}

constexpr int NSLOT=3, SLOTB=8192;
constexpr int LDS_K=0, LDS_V=NSLOT*SLOTB, LDS_WS=2*NSLOT*SLOTB, LDS_OST=LDS_WS+NW*64*4, LDS_BYTES=LDS_OST+NW*4096;
constexpr float C2=0.125f*1.4426950408889634f;
__device__ __forceinline__ void glds16(const void*gsrc,unsigned lds_dst){unsigned keep;
  asm volatile("s_mov_b32 %0, m0\n\ts_mov_b32 m0, %2\n\ts_nop 0\n\tglobal_load_lds_dwordx4 %1, off\n\ts_mov_b32 m0, %0":"=&s"(keep):"v"(gsrc),"s"(lds_dst):"memory");}
__device__ __forceinline__ float max3f(float a,float b,float c){float r;asm("v_max3_f32 %0, %1, %2, %3":"=v"(r):"v"(a),"v"(b),"v"(c));return r;}
__device__ __forceinline__ float max2f(float a,float b){float r;asm("v_max_f32_e32 %0, %1, %2":"=v"(r):"v"(a),"v"(b));return r;}
__device__ __forceinline__ float fadd_s(float a,float b){float r;asm("v_add_f32_e32 %0, %1, %2":"=v"(r):"v"(a),"v"(b));return r;}
__device__ __forceinline__ float fsub_s(float a,float b){float r;asm("v_sub_f32_e32 %0, %1, %2":"=v"(r):"v"(a),"v"(b));return r;}
typedef float f32x2_t __attribute__((ext_vector_type(2))); typedef __bf16 bf16x2_t __attribute__((ext_vector_type(2)));
__device__ __forceinline__ unsigned cvtpk_s(float lo,float hi){f32x2_t v={lo,hi};bf16x2_t b=__builtin_convertvector(v,bf16x2_t);return __builtin_bit_cast(unsigned,b);}
#define WAIT_BAR(N) asm volatile("s_waitcnt vmcnt(" #N ") lgkmcnt(0)\n\ts_barrier":::"memory")

__device__ __forceinline__ void qkt(f32x16&p0,f32x16&p1,const char*Kslot,const bf16x8*qr,int r32,int hi){
  const char*kb=Kslot+hi*1024+r32*16;
  #pragma unroll
  for(int d0=0;d0<4;++d0){
    const bf16x8 b0=*reinterpret_cast<const bf16x8*>(kb+d0*2048);
    const bf16x8 b1=*reinterpret_cast<const bf16x8*>(kb+d0*2048+512);
    if(d0==0){p0=__builtin_amdgcn_mfma_f32_32x32x16_bf16(b0,qr[0],f32x16{},0,0,0);p1=__builtin_amdgcn_mfma_f32_32x32x16_bf16(b1,qr[0],f32x16{},0,0,0);}
    else{p0=__builtin_amdgcn_mfma_f32_32x32x16_bf16(b0,qr[d0],p0,0,0,0);p1=__builtin_amdgcn_mfma_f32_32x32x16_bf16(b1,qr[d0],p1,0,0,0);}}
}
typedef __attribute__((address_space(3))) const char* lds_cptr;
typedef short v4i16_t __attribute__((ext_vector_type(4)));
__device__ __forceinline__ void kload8(bf16x8*kf,lds_cptr kp){
  kf[0]=*(const __attribute__((address_space(3))) bf16x8*)(kp);      kf[1]=*(const __attribute__((address_space(3))) bf16x8*)(kp+512);
  kf[2]=*(const __attribute__((address_space(3))) bf16x8*)(kp+2048); kf[3]=*(const __attribute__((address_space(3))) bf16x8*)(kp+2560);
  kf[4]=*(const __attribute__((address_space(3))) bf16x8*)(kp+4096); kf[5]=*(const __attribute__((address_space(3))) bf16x8*)(kp+4608);
  kf[6]=*(const __attribute__((address_space(3))) bf16x8*)(kp+6144); kf[7]=*(const __attribute__((address_space(3))) bf16x8*)(kp+6656);
}
__device__ __forceinline__ void kload2(bf16x8*kf,lds_cptr kp,int j){ kf[2*j]=*(const __attribute__((address_space(3))) bf16x8*)(kp+j*2048); kf[2*j+1]=*(const __attribute__((address_space(3))) bf16x8*)(kp+j*2048+512); }
__device__ __forceinline__ s16x4 vtr(lds_cptr p){ return __builtin_bit_cast(s16x4,__builtin_amdgcn_ds_read_tr16_b64_v4i16((__attribute__((address_space(3))) v4i16_t*)p)); }
__device__ __forceinline__ float rowmax(const f32x16&p0,const f32x16&p1){
  float a=max3f(p0[0],p0[1],p1[0]),b=max3f(p0[2],p0[3],p1[1]);a=max3f(a,p1[2],p1[3]);
  #pragma unroll
  for(int r=4;r<16;r+=4){a=max3f(a,p0[r],p0[r+1]);b=max3f(b,p0[r+2],p0[r+3]);a=max3f(a,p1[r],p1[r+1]);b=max3f(b,p1[r+2],p1[r+3]);}
  const float m=max2f(a,b);
  auto rr=__builtin_amdgcn_permlane32_swap(__float_as_uint(m),__float_as_uint(m),false,false);
  return max2f(__uint_as_float(rr[0]),__uint_as_float(rr[1]));
}
__device__ __forceinline__ void pv(f32x16*o,int vb,bf16x8 pa0,bf16x8 pa1,bf16x8 pa2,bf16x8 pa3){
  #pragma unroll
  for(int d0=0;d0<2;++d0){s16x4 lo[4],hi[4];
    #pragma unroll
    for(int ks=0;ks<4;++ks){
      asm volatile("ds_read_b64_tr_b16 %0,%1 offset:%c2":"=&v"(lo[ks]):"v"(vb),"i"(d0*4096+ks*1024):"memory");
      asm volatile("ds_read_b64_tr_b16 %0,%1 offset:%c2":"=&v"(hi[ks]):"v"(vb),"i"(d0*4096+ks*1024+512):"memory");}
    asm volatile("s_waitcnt lgkmcnt(0)":::"memory");SBAR();
    #define PK(k) (bf16x8){lo[k][0],lo[k][1],lo[k][2],lo[k][3],hi[k][0],hi[k][1],hi[k][2],hi[k][3]}
    o[d0]=__builtin_amdgcn_mfma_f32_32x32x16_bf16(pa0,PK(0),o[d0],0,0,0);
    o[d0]=__builtin_amdgcn_mfma_f32_32x32x16_bf16(pa1,PK(1),o[d0],0,0,0);
    o[d0]=__builtin_amdgcn_mfma_f32_32x32x16_bf16(pa2,PK(2),o[d0],0,0,0);
    o[d0]=__builtin_amdgcn_mfma_f32_32x32x16_bf16(pa3,PK(3),o[d0],0,0,0);
    #undef PK
  }
}

#ifndef ATTN_STORE16
#define ATTN_STORE16(p,v) (*(u32x4*)(p)=(v))
#endif
template<int THRL> __device__ __forceinline__ void attn_unit(int b,int h,int qb,const bf16*Q,const bf16*__restrict__ K,const bf16*__restrict__ V,bf16*O,char*shm,lds_cptr btab,lds_cptr zblk){
  const int tid=threadIdx.x,lane=tid&63,r32=lane&31,hi=lane>>5; const int wid=__builtin_amdgcn_readfirstlane(tid>>6);
  const long rowbase=(long)b*SEQ; const int q0=qb*QB;
  const bf16*Qw=Q+(rowbase+q0+wid*QBLK)*DM+h*D;
  const bf16*Kh=K+rowbase*DM+h*D,*Vh=V+rowbase*DM+h*D;
  const unsigned lds0=(unsigned)(uintptr_t)shm;
  float*wsf=(float*)(shm+LDS_WS)+wid*64;
  const bf16*ksrc=Kh+(long)lane*DM+wid*8;
  const bf16*vsrc=Vh+(long)(16*(wid&3)+(lane>>2))*DM+(wid>>2)*32+(lane&3)*8;
  const unsigned kdst=lds0+LDS_K+wid*1024, vdst=lds0+LDS_V+wid*1024;
  #define DMA_K(t,slot) glds16(ksrc+(long)(t)*KVBLK*DM,(unsigned)__builtin_amdgcn_readfirstlane(kdst+(slot)))
  #define DMA_V(t,slot) glds16(vsrc+(long)(t)*KVBLK*DM,(unsigned)__builtin_amdgcn_readfirstlane(vdst+(slot)))
  const int vb0=(int)(lds0+LDS_V)+((lane>>4)&1)*32+(lane&3)*8+(4*hi+((lane&15)>>2))*64;
  const char*Kbase=shm+LDS_K; bf16x8 kf[8];
  const lds_cptr shm3=(lds_cptr)shm; const lds_cptr kp0=shm3+LDS_K+hi*1024+r32*16; const lds_cptr vp0=shm3+LDS_V+((lane>>4)&1)*32+(lane&3)*8+(4*hi+((lane&15)>>2))*64;
  const int NT=(q0+QB)/KVBLK;
  DMA_K(0,0);DMA_V(0,0);DMA_K(1,SLOTB);
  bf16x8 qr[4];
  #pragma unroll
  for(int d0=0;d0<4;++d0)qr[d0]=*reinterpret_cast<const bf16x8*>(&Qw[(long)r32*DM+d0*16+hi*8]);
  float mhat=0.f,l_reg=0.f;f32x16 o[2];o[0]=f32x16{};o[1]=f32x16{};unsigned qx1=0x00003F80u,qx2=0u;
  const int qrel=wid*QBLK+r32;
  const lds_cptr bx0=hi?zblk:btab+r32*16; const int bxs=hi?0:1024;
  #define KXLD(t_,kxa,kxb) do{ const lds_cptr p_=bx0+(t_)*bxs; kxa=*(const __attribute__((address_space(3))) bf16x8*)(p_); kxb=*(const __attribute__((address_space(3))) bf16x8*)(p_+512); }while(0)
  #define QX() __builtin_bit_cast(bf16x8,(u32x4){0x3F803F80u,qx1,qx2,0u})
  #define SETM() do{ const float mm_=-mhat; qx1=cvtpk_s(1.0f,mm_); const float r1_=mm_-__uint_as_float(qx1&0xffff0000u); const unsigned t2_=cvtpk_s(r1_,r1_); const float r2_=r1_-__uint_as_float(t2_<<16); qx2=cvtpk_s(r1_,r2_); }while(0)
  #define CMASK(P0,P1,t) do{int jb_=(t)-(NT-4); if(jb_>=0)cmask(P0,P1,jb_,qrel,hi);}while(0)
  bool resc=false;
  #define START(P0,P1) do{ const float rm=rowmax(P0,P1); resc=false; \
    { const float dl=rm; mhat=fadd_s(mhat,dl); \
      _Pragma("unroll") for(int r=0;r<16;++r){P0[r]=fsub_s(P0[r],dl);P1[r]=fsub_s(P1[r],dl);} \
      SETM(); } \
    _Pragma("unroll") for(int r=0;r<16;++r)P0[r]=__builtin_amdgcn_exp2f(P0[r]); }while(0)
  #define RESC() do{ if(resc){ asm volatile("s_waitcnt lgkmcnt(0)":::"memory"); \
      _Pragma("unroll") for(int d_=0;d_<2;++d_) _Pragma("unroll") for(int r=0;r<16;++r)o[d_][r]*=wsf[crow(r,hi)]; } }while(0)
  f32x16 pA0,pA1,pB0,pB1;
  int sl_prev=0,sl_cur=0,sl_next=SLOTB;
  #define ROT() do{sl_prev=sl_cur;sl_cur=sl_next;sl_next=(sl_next==(NSLOT-1)*SLOTB)?0:sl_next+SLOTB;}while(0)
  DMA_K(2,2*SLOTB);
  WAIT_BAR(3);
  qkt(pA0,pA1,Kbase,qr,r32,hi);
  { bf16x8 kxa,kxb; KXLD(0,kxa,kxb); pA0=__builtin_amdgcn_mfma_f32_32x32x16_bf16(kxa,QX(),pA0,0,0,0); pA1=__builtin_amdgcn_mfma_f32_32x32x16_bf16(kxb,QX(),pA1,0,0,0); }
  asm volatile("s_nop 15\n\ts_nop 7":"+v"(pA0),"+v"(pA1));CMASK(pA0,pA1,0);
  START(pA0,pA1);
  _Pragma("unroll") for(int r=0;r<16;++r)pA1[r]=__builtin_amdgcn_exp2f(pA1[r]);
  WAIT_BAR(0);
  DMA_K(3,0);DMA_V(1,SLOTB);
  ROT();
  kload8(kf,kp0+sl_cur);
  WAIT_BAR(2);
  s16x4 vlo[8],vhi[8]; u32x4 pw0,pw1,pw2,pw3;
  #define PKW(P,B) cvtpk_s(P[B],P[B+1])
  #define PAF(k) __builtin_bit_cast(bf16x8,pw##k)
  #define VFR(i) (bf16x8){vlo[i][0],vlo[i][1],vlo[i][2],vlo[i][3],vhi[i][0],vhi[i][1],vhi[i][2],vhi[i][3]}
  #define PIN(x) asm volatile("":"+v"(x))
  #define MX3(a,b,c) __builtin_fmaxf(__builtin_fmaxf((a),(b)),(c))
  #define GAPA(MF,A0,A1,A2,A3,W0,W1,PW) do{ MF; sacc+=A0; sacc+=A1; sacc+=A2; sacc+=A3; PIN(sacc); W0; W1; PIN(PW); SBAR(); }while(0)
  #define EX(v) __builtin_amdgcn_exp2f(v)
  #define GAPB(MF,X,B) do{ MF; X[B]=EX(X[B]); X[B+1]=EX(X[B+1]); X[B+2]=EX(X[B+2]); X[B+3]=EX(X[B+3]); PIN(X); SBAR(); }while(0)
  #define VRD(i) do{ vlo[i]=vtr(vp_+(((i)>>2)*4096+((i)&3)*1024)); vhi[i]=vtr(vp_+(((i)>>2)*4096+((i)&3)*1024+512)); }while(0)
  #define KRD(G,j) do{ if(G){ kload2(kf,kp0+sl_next,j); SBAR(); } }while(0)
  #define STEP(C0,C1,P0,P1,t,GK,GV,GL) do{ SBAR(); \
    const lds_cptr vp_=vp0+sl_prev; \
    bf16x8 kxa_,kxb_; KXLD(t,kxa_,kxb_); \
    VRD(0); SBAR(); float sacc=(P0[0]+P0[1]); \
    GAPA(C0=__builtin_amdgcn_mfma_f32_32x32x16_bf16(kf[0],qr[0],f32x16{},0,0,0), P0[2],P0[3],P0[4],P0[5],     pw0[0]=PKW(P0,0), pw0[1]=PKW(P0,2), pw0); \
    VRD(4); SBAR(); GAPA(C1=__builtin_amdgcn_mfma_f32_32x32x16_bf16(kf[1],qr[0],f32x16{},0,0,0), P0[6],P0[7],P0[8],P0[9],     pw0[2]=PKW(P0,4), pw0[3]=PKW(P0,6), pw0); \
    VRD(1); SBAR(); GAPA(C0=__builtin_amdgcn_mfma_f32_32x32x16_bf16(kf[2],qr[1],C0,0,0,0),   P0[10],P0[11],P0[12],P0[13], pw1[0]=PKW(P0,8), pw1[1]=PKW(P0,10), pw1); \
    VRD(5); SBAR(); GAPA(C1=__builtin_amdgcn_mfma_f32_32x32x16_bf16(kf[3],qr[1],C1,0,0,0),   P0[14],P0[15],P1[0],P1[1],   pw1[2]=PKW(P0,12),pw1[3]=PKW(P0,14), pw1); \
    VRD(2); SBAR(); GAPA(C0=__builtin_amdgcn_mfma_f32_32x32x16_bf16(kf[4],qr[2],C0,0,0,0),   P1[2],P1[3],P1[4],P1[5],     pw2[0]=PKW(P1,0), pw2[1]=PKW(P1,2), pw2); \
    VRD(6); SBAR(); GAPA(C1=__builtin_amdgcn_mfma_f32_32x32x16_bf16(kf[5],qr[2],C1,0,0,0),   P1[6],P1[7],P1[8],P1[9],     pw2[2]=PKW(P1,4), pw2[3]=PKW(P1,6), pw2); \
    VRD(3); SBAR(); GAPA(C0=__builtin_amdgcn_mfma_f32_32x32x16_bf16(kf[6],qr[3],C0,0,0,0),   P1[10],P1[11],P1[12],P1[13], pw3[0]=PKW(P1,8), pw3[1]=PKW(P1,10), pw3); \
    VRD(7); SBAR(); GAPA(C1=__builtin_amdgcn_mfma_f32_32x32x16_bf16(kf[7],qr[3],C1,0,0,0),   P1[14],P1[15],0.f,0.f,       pw3[2]=PKW(P1,12),pw3[3]=PKW(P1,14), pw3); \
    C0=__builtin_amdgcn_mfma_f32_32x32x16_bf16(kxa_,QX(),C0,0,0,0); C1=__builtin_amdgcn_mfma_f32_32x32x16_bf16(kxb_,QX(),C1,0,0,0); SBAR(); \
    l_reg+=sacc; \
    if(GK){DMA_K((t)+3,sl_cur);} if(GV){DMA_V((t)+1,sl_next);} \
    CMASK(C0,C1,t); \
    { float a=MX3(C0[0],C0[1],C1[0]),b=MX3(C0[2],C0[3],C1[1]); a=MX3(a,C1[2],C1[3]); \
      _Pragma("unroll") for(int r=4;r<16;r+=4){a=MX3(a,C0[r],C0[r+1]);b=MX3(b,C0[r+2],C0[r+3]);a=MX3(a,C1[r],C1[r+1]);b=MX3(b,C1[r+2],C1[r+3]);} \
      float rm=__builtin_fmaxf(a,b); { auto rr=__builtin_amdgcn_permlane32_swap(__float_as_uint(rm),__float_as_uint(rm),false,false); rm=__builtin_fmaxf(__uint_as_float(rr[0]),__uint_as_float(rr[1])); } \
      resc=false; \
      if(__builtin_expect(__any(rm>(float)THRL),0)){ const float dl=__builtin_fmaxf(rm,0.f); mhat+=dl; \
        _Pragma("unroll") for(int r=0;r<16;++r){C0[r]-=dl;C1[r]-=dl;} \
        SETM(); \
        const float f=__builtin_amdgcn_exp2f(-dl); l_reg*=f; if(hi==0)wsf[r32]=f; resc=true; } } \
    SBAR(); \
    GAPB(o[0]=__builtin_amdgcn_mfma_f32_32x32x16_bf16(PAF(0),VFR(0),o[0],0,0,0), C0,0); \
    GAPB(o[1]=__builtin_amdgcn_mfma_f32_32x32x16_bf16(PAF(0),VFR(4),o[1],0,0,0), C0,4); \
    KRD(GL,0); GAPB(o[0]=__builtin_amdgcn_mfma_f32_32x32x16_bf16(PAF(1),VFR(1),o[0],0,0,0), C0,8); \
    KRD(GL,1); GAPB(o[1]=__builtin_amdgcn_mfma_f32_32x32x16_bf16(PAF(1),VFR(5),o[1],0,0,0), C0,12); \
    KRD(GL,2); GAPB(o[0]=__builtin_amdgcn_mfma_f32_32x32x16_bf16(PAF(2),VFR(2),o[0],0,0,0), C1,0); \
    KRD(GL,3); GAPB(o[1]=__builtin_amdgcn_mfma_f32_32x32x16_bf16(PAF(2),VFR(6),o[1],0,0,0), C1,4); \
    GAPB(o[0]=__builtin_amdgcn_mfma_f32_32x32x16_bf16(PAF(3),VFR(3),o[0],0,0,0), C1,8); \
    GAPB(o[1]=__builtin_amdgcn_mfma_f32_32x32x16_bf16(PAF(3),VFR(7),o[1],0,0,0), C1,12); \
    }while(0)
  int t=1;
  #undef CMASK
  #define CMASK(P0,P1,t) do{}while(0)
  for(;t+5<NT;t+=2){
    STEP(pB0,pB1,pA0,pA1,t,true,true,true);     WAIT_BAR(2); RESC(); ROT();
    STEP(pA0,pA1,pB0,pB1,t+1,true,true,true);   WAIT_BAR(2); RESC(); ROT();
  }
  #undef CMASK
  #define CMASK(P0,P1,t) do{int jb_=(t)-(NT-4); if(jb_>=0)cmask(P0,P1,jb_,qrel,hi);}while(0)
  #define ENDW(tt) do{ if((tt)+3<NT){WAIT_BAR(2);} else if((tt)+2<NT){WAIT_BAR(1);} else {WAIT_BAR(0);} }while(0)
  for(;t+1<NT;t+=2){
    STEP(pB0,pB1,pA0,pA1,t,(t+3<NT),(t+1<NT),(t+1<NT));       ENDW(t);   RESC(); ROT();
    STEP(pA0,pA1,pB0,pB1,t+1,(t+4<NT),(t+2<NT),(t+2<NT));     ENDW(t+1); RESC(); ROT();
  }
  STEP(pB0,pB1,pA0,pA1,NT-1,false,false,false); RESC();
  { float sacc=pB0[0]+pB0[1]; _Pragma("unroll") for(int r=2;r<16;++r)sacc+=pB0[r]; _Pragma("unroll") for(int r=0;r<16;++r)sacc+=pB1[r]; l_reg+=sacc;
    pw0=(u32x4){PKW(pB0,0),PKW(pB0,2),PKW(pB0,4),PKW(pB0,6)};pw1=(u32x4){PKW(pB0,8),PKW(pB0,10),PKW(pB0,12),PKW(pB0,14)};pw2=(u32x4){PKW(pB1,0),PKW(pB1,2),PKW(pB1,4),PKW(pB1,6)};pw3=(u32x4){PKW(pB1,8),PKW(pB1,10),PKW(pB1,12),PKW(pB1,14)};
    SBAR(); pv(o,vb0+sl_cur,PAF(0),PAF(1),PAF(2),PAF(3)); }
  #undef PKW
  #undef PAF
  #undef VFR
  #undef PIN
  #undef MX3
  #undef GAPA
  #undef GAPB
  #undef EX
  #undef VRD
  #undef KRD
  #undef STEP
  #undef ENDW
  {auto rr=__builtin_amdgcn_permlane32_swap(__float_as_uint(l_reg),__float_as_uint(l_reg),false,false);l_reg=__uint_as_float(rr[0])+__uint_as_float(rr[1]);}
  if(hi==0)wsf[32+r32]=l_reg;asm volatile("s_waitcnt lgkmcnt(0)":::"memory");
  float rli[16];
  #pragma unroll
  for(int r=0;r<16;++r)rli[r]=__builtin_amdgcn_rcpf(wsf[32+crow(r,hi)]);
  bf16*Ow=O+(rowbase+q0+wid*QBLK)*DM+h*D;
  { bf16*stg=(bf16*)(shm+LDS_OST)+wid*2048;
    #pragma unroll
    for(int r=0;r<16;++r){const int orow=crow(r,hi);
      #pragma unroll
      for(int d0=0;d0<2;++d0)stg[orow*64+d0*32+r32]=__float2bfloat16(o[d0][r]*rli[r]);}
    asm volatile("s_waitcnt lgkmcnt(0)":::"memory");
    #pragma unroll
    for(int i=0;i<4;++i){const int row=i*8+(lane>>3),ch=lane&7; const u32x4 v=*(const u32x4*)(stg+row*64+ch*8); ATTN_STORE16(Ow+(long)row*DM+ch*8,v);} }
  asm volatile("s_waitcnt lgkmcnt(0)\n\ts_barrier":::"memory");
  #undef DMA_K
  #undef DMA_V
  #undef CMASK
  #undef START
  #undef RESC
  #undef ROT
  #undef KXLD
  #undef QX
  #undef SETM
}
constexpr int ATTN_LDS_BYTES=LDS_BYTES;
struct AttnTensors { const bf16* Q; const bf16* K; const bf16* V; bf16* O; };
struct AttnUnit { int bh; int qb; };
struct StaticOrder {
  int vcu;
  __device__ __forceinline__ explicit StaticOrder(int v):vcu(v){}
  __device__ __forceinline__ bool next(int i,AttnUnit&u)const{ if(i>=4)return false; const int s=vcu&1; u.bh=vcu>>1; u.qb=(i==0)?7-s:(i==1)?4+s:(i==2)?3-s:s; return true; }
  __device__ __forceinline__ void a_ready(const AttnUnit&)const{}
  __device__ __forceinline__ void done(const AttnUnit&)const{}
};
template<class Sched,int THRL=8> __device__ __forceinline__ void attn_phase(char*lds,const AttnTensors&T,const Sched&S,lds_cptr btab,lds_cptr zblk){
  AttnUnit u;
  for(int i=0;S.next(i,u);++i){ S.a_ready(u); attn_unit<THRL>(u.bh/NHEAD,u.bh%NHEAD,u.qb,T.Q,T.K,T.V,T.O,lds,btab,zblk); S.done(u); }
}
#undef SBAR
#undef WAIT_BAR
}
#define XB_TMO      128
#define XB_XCNT(j)  (256  + 64 * (j))
#define XB_XSUB(j)  (1280 + 64 * (j))
#define XB_XGEN(j)  (2304 + 64 * (j))
#define XB_TOP      3328
#define XB_TOPGEN   3392
#define XCD_BAR_WORDS 3456
#define XB_SPIN_CAP (1u << 18)

__device__ __forceinline__ unsigned xb_ld(unsigned* p)              { return __hip_atomic_load(p, __ATOMIC_RELAXED, __HIP_MEMORY_SCOPE_AGENT); }
__device__ __forceinline__ unsigned xb_add(unsigned* p, unsigned v) { return __hip_atomic_fetch_add(p, v, __ATOMIC_RELAXED, __HIP_MEMORY_SCOPE_AGENT); }
__device__ __forceinline__ unsigned xb_xcc_id() { return (unsigned)__builtin_amdgcn_s_getreg((3 << 11) | 20) & 0xFu; }
#define XB_SPIN(cond, bar) do { unsigned _sp = 0; while (cond) { __builtin_amdgcn_s_sleep(1); \
    if ((++_sp & 255u) == 0u) { if (xb_ld(&(bar)[XB_TMO])) break; if (_sp > XB_SPIN_CAP) { atomicAdd(&(bar)[XB_TMO], 1u); break; } } } } while (0)

struct XcdBarrier {
    unsigned* bar; unsigned x;
    volatile LAS unsigned* st;
};

__device__ __forceinline__ XcdBarrier xcd_barrier_post(unsigned* bar, volatile LAS unsigned* st) {
    XcdBarrier b; b.bar = bar; b.x = xb_xcc_id(); b.st = st;
    if (threadIdx.x == 0) (void)xb_add(&bar[XB_XCNT(b.x)], 1u);
    return b;
}
__device__ __forceinline__ void xcd_barrier_complete(unsigned* bar, unsigned x, unsigned& nloc, unsigned& nx) {
    const unsigned G = gridDim.x * gridDim.y * gridDim.z;
    unsigned sum, cnt, mine, sp = 0u;
    for (;;) {
        sum = 0u; cnt = 0u; mine = 0u;
#pragma unroll
        for (unsigned j = 0; j < 16; ++j) { const unsigned c = xb_ld(&bar[XB_XCNT(j)]); sum += c; cnt += (c > 0u) ? 1u : 0u; mine = (j == x) ? c : mine; }
        if (sum == G) break;
        __builtin_amdgcn_s_sleep(1);
        if ((++sp & 255u) == 0u) { if (xb_ld(&bar[XB_TMO])) break; if (sp > XB_SPIN_CAP) { atomicAdd(&bar[XB_TMO], 1u); break; } }
    }
    nloc = mine > 0u ? mine : 1u; nx = cnt > 0u ? cnt : 1u;
}

__device__ __forceinline__ void xcd_barrier(const XcdBarrier& b) {
    asm volatile("s_waitcnt vmcnt(0)" ::: "memory");
    __syncthreads();
    if (threadIdx.x == 0) {
        unsigned* bar = b.bar;
        __builtin_amdgcn_s_waitcnt(0);
        unsigned nloc = b.st[0], nx = b.st[1];
        if (nloc == 0u) { xcd_barrier_complete(bar, b.x, nloc, nx); b.st[0] = nloc; b.st[1] = nx; }
        const unsigned old = xb_add(&bar[XB_XSUB(b.x)], 1u);
        const unsigned gen = old / nloc;
        if (old + 1u == (gen + 1u) * nloc) {
            __builtin_amdgcn_fence(__ATOMIC_RELEASE, "agent");
            asm volatile("s_waitcnt vmcnt(0)" ::: "memory");
            const unsigned og = xb_add(&bar[XB_TOP], 1u);
            const unsigned tg = og / nx;
            if (og + 1u == (tg + 1u) * nx) xb_add(&bar[XB_TOPGEN], 1u);
            else XB_SPIN(xb_ld(&bar[XB_TOPGEN]) == tg, bar);
            __builtin_amdgcn_fence(__ATOMIC_ACQUIRE, "agent");
            xb_add(&bar[XB_XGEN(b.x)], 1u);
            asm volatile("s_waitcnt vmcnt(0)" ::: "memory");
        } else {
            XB_SPIN(xb_ld(&bar[XB_XGEN(b.x)]) == gen, bar);
            __builtin_amdgcn_fence(__ATOMIC_ACQUIRE, "agent");
            asm volatile("s_waitcnt vmcnt(0)" ::: "memory");
        }
    }
    __syncthreads();
}

struct Frame {
    LAS unsigned char* lds;
    volatile LAS unsigned* MISC;
    gu32* ctl;
    int tid, lane, wave, vcu, G;
    const float *x_p, *x_s, *state_conv, *cache_k, *cache_v, *cache_lf, *norm_ffn, *ffn_w_in, *ffn_w_out, *norm_mix, *conv_w_in, *conv_w, *conv_w_out, *attn_w_in, *attn_bf, *q_norm, *k_norm, *attn_w_out;
    float* out; unsigned char* ws;
};
__device__ __forceinline__ bf16* ws_bf(const Frame& F, size_t off) { return (bf16*)(F.ws + off); }

__device__ __forceinline__ float wave_sum(float v) {
#pragma unroll
    for (int o = 1; o < 64; o <<= 1) v += __shfl_xor(v, o);
    return v;
}

__device__ __forceinline__ void wprep_item(const float* W, int ldw, int K, const float* gain, int col0, int nvalid, bf16* WT, int dst_row0, int kb, LAS float* scr, int lane) {
    const int k0 = 64 * kb, c = lane & 31;
#pragma unroll 8
    for (int i = 0; i < 32; ++i) { const int kk = 2 * i + (lane >> 5); float v = 0.f; if (c < nvalid) v = W[(size_t)(k0 + kk) * ldw + col0 + c]; if (gain) v *= gain[k0 + kk]; scr[kk * 33 + c] = v; }
    LDS_WAIT(); asm volatile("" ::: "memory");
    const int c8 = lane & 7;
#pragma unroll
    for (int j = 0; j < 4; ++j) { const int n = (lane >> 3) + 8 * j; const LAS float* s = scr + (8 * c8) * 33 + n;
        v4u o; o.x = pk2(s[0 * 33], s[1 * 33]); o.y = pk2(s[2 * 33], s[3 * 33]); o.z = pk2(s[4 * 33], s[5 * 33]); o.w = pk2(s[6 * 33], s[7 * 33]);
        *(GAS v4u*)(WT + (size_t)(dst_row0 + n) * K + k0 + 8 * c8) = o; }
    LDS_WAIT(); asm volatile("" ::: "memory");
}
__device__ __forceinline__ int pair_col(int g, int base, int half_off) { const int tile = g >> 3, bj = (g >> 2) & 1, i = g & 3; return base + bj * half_off + 128 * tile + 32 * i; }
__device__ __forceinline__ int head_col(int g) { const int tile = g >> 3, bj = (g >> 2) & 1, wc = g & 3; return 256 * tile + 64 * wc + 32 * bj; }

__device__ __forceinline__ void p0_prologue(Frame& F) {
    LAS float* scr = (LAS float*)(F.lds + RING_OFF + F.wave * 16384);
    const int gw = F.vcu * NWAVES + F.wave, NGW = F.G * NWAVES, lane = F.lane;
    constexpr int KB1 = D / 64, KB2 = FF / 64;
    constexpr int I_FFI = (2 * FF / 32) * KB1, I_FFO = (D / 32) * KB2;
    constexpr int I_CI1 = 32 * KB1, I_CI2 = 64 * KB1, I_CO = 32 * KB1, I_AQK = 64 * KB1, I_AV = 32 * KB1, I_AF = 8 * KB1, I_AO = 32 * KB1;
    constexpr int NITEMS = 4 * I_FFI + 4 * I_FFO + I_CI1 + I_CI2 + I_CO + I_AQK + I_AV + I_AF + I_AO;
    for (int it = gw; it < NITEMS; it += NGW) {
        int r = it;
        if (r < 4 * I_FFI) { const int w = r / I_FFI; r -= w * I_FFI; const int g = r / KB1, kb = r % KB1;
            wprep_item(F.ffn_w_in + (size_t)w * D * 2 * FF, 2 * FF, D, F.norm_ffn + w * D, pair_col(g, 0, FF), 32, ws_bf(F, WS_FFI + w * SZ_FFI), 32 * g, kb, scr, lane); continue; }
        r -= 4 * I_FFI;
        if (r < 4 * I_FFO) { const int w = r / I_FFO; r -= w * I_FFO; const int g = r / KB2, kb = r % KB2;
            wprep_item(F.ffn_w_out + (size_t)w * FF * D, D, FF, nullptr, 32 * g, 32, ws_bf(F, WS_FFO + w * SZ_FFO), 32 * g, kb, scr, lane); continue; }
        r -= 4 * I_FFO;
        if (r < I_CI1) { const int g = r / KB1, kb = r % KB1; wprep_item(F.conv_w_in, 3 * D, D, F.norm_mix, 32 * g, 32, ws_bf(F, WS_CI), 32 * g, kb, scr, lane); continue; }
        r -= I_CI1;
        if (r < I_CI2) { const int g = r / KB1, kb = r % KB1; wprep_item(F.conv_w_in, 3 * D, D, F.norm_mix, pair_col(g, D, D), 32, ws_bf(F, WS_CI), D + 32 * g, kb, scr, lane); continue; }
        r -= I_CI2;
        if (r < I_CO) { const int g = r / KB1, kb = r % KB1; wprep_item(F.conv_w_out, D, D, nullptr, 32 * g, 32, ws_bf(F, WS_CO), 32 * g, kb, scr, lane); continue; }
        r -= I_CO;
        if (r < I_AQK) { const int g = r / KB1, kb = r % KB1; wprep_item(F.attn_w_in, 3 * D + NH, D, F.norm_mix + D, head_col(g), 32, ws_bf(F, WS_AI), 32 * g, kb, scr, lane); continue; }
        r -= I_AQK;
        if (r < I_AV) { const int g = r / KB1, kb = r % KB1; wprep_item(F.attn_w_in, 3 * D + NH, D, F.norm_mix + D, 2 * D + 32 * g, 32, ws_bf(F, WS_AI), 2 * D + 32 * g, kb, scr, lane); continue; }
        r -= I_AV;
        if (r < I_AF) { const int g = r / KB1, kb = r % KB1; wprep_item(F.attn_w_in, 3 * D + NH, D, F.norm_mix + D, 3 * D, g == 0 ? NH : 0, ws_bf(F, WS_AI), 3 * D + 32 * g, kb, scr, lane); continue; }
        r -= I_AF;
        { const int g = r / KB1, kb = r % KB1; wprep_item(F.attn_w_out, D, D, nullptr, 32 * g, 32, ws_bf(F, WS_AO), 32 * g, kb, scr, lane); }
    }
    bf16* XB = ws_bf(F, WS_XB); float* RS = (float*)(F.ws + WS_RS);
    for (int m = gw; m < M; m += NGW) {
        const float* src = m < MP ? F.x_p + (size_t)m * D : F.x_s + (size_t)(m - MP) * D;
        const GAS pg8::f32x4* xr = (const GAS pg8::f32x4*)src + lane; float ss = 0.f;
        GAS unsigned long long* o8 = (GAS unsigned long long*)(XB + (size_t)m * D) + lane;
#pragma unroll
        for (int j = 0; j < 4; ++j) { const pg8::f32x4 v = xr[64 * j]; ss += (v[0] * v[0] + v[1] * v[1]) + (v[2] * v[2] + v[3] * v[3]);
            o8[64 * j] = (unsigned long long)pk2(v[0], v[1]) | ((unsigned long long)pk2(v[2], v[3]) << 32); }
        ss = wave_sum(ss);
        if (lane == 0) *(pg8::f32x4*)(RS + (size_t)m * 4) = (pg8::f32x4){ss, 0.f, 0.f, 0.f};
    }
}

__device__ __forceinline__ void unpack8(const v4u w, float (&f)[8]) { f[0] = bflo(w.x); f[1] = bfhi(w.x); f[2] = bflo(w.y); f[3] = bfhi(w.y); f[4] = bflo(w.z); f[5] = bfhi(w.z); f[6] = bflo(w.w); f[7] = bfhi(w.w); }
__device__ __forceinline__ void conv_ew_phase(Frame& F) {
    bf16* G = ws_bf(F, WS_BIG); const bf16* U = ws_bf(F, WS_BIG + SZ_ACT);
    const int gw = F.vcu * NWAVES + F.wave, NGW = F.G * NWAVES, lane = F.lane;
    constexpr int RCH = 16, NITEMS = (M / RCH) * 2;
    for (int it = gw; it < NITEMS; it += NGW) {
        const int r0 = (it >> 1) * RCH, c = (it & 1) * 512 + lane * 8;
        float w0[8], w1[8], w2[8], um2[8], um1[8];
#pragma unroll
        for (int j = 0; j < 8; ++j) { w0[j] = F.conv_w[c + j]; w1[j] = F.conv_w[D + c + j]; w2[j] = F.conv_w[2 * D + c + j]; }
        int t0, b; bool prompt = r0 < MP;
        if (prompt) { t0 = r0 & (SEQ - 1); b = r0 >> 11; } else { t0 = (r0 - MP) & (DSEQ - 1); b = (r0 - MP) >> 6; }
        if (t0 == 0) {
            if (prompt) {
#pragma unroll
                for (int j = 0; j < 8; ++j) { um2[j] = 0.f; um1[j] = 0.f; }
            } else {
#pragma unroll
                for (int j = 0; j < 8; ++j) { um2[j] = F.state_conv[((size_t)b * 2 + 0) * D + c + j]; um1[j] = F.state_conv[((size_t)b * 2 + 1) * D + c + j]; }
            }
        } else {
            unpack8(*(const GAS v4u*)(U + (size_t)(r0 - 2) * D + c), um2); unpack8(*(const GAS v4u*)(U + (size_t)(r0 - 1) * D + c), um1);
        }
        for (int i = 0; i < RCH; ++i) {
            float uc[8], gg[8], z[8];
            unpack8(*(const GAS v4u*)(U + (size_t)(r0 + i) * D + c), uc); unpack8(*(const GAS v4u*)(G + (size_t)(r0 + i) * D + c), gg);
#pragma unroll
            for (int j = 0; j < 8; ++j) { z[j] = gg[j] * (w0[j] * um2[j] + w1[j] * um1[j] + w2[j] * uc[j]); um2[j] = um1[j]; um1[j] = uc[j]; }
            v4u o; o.x = pk2(z[0], z[1]); o.y = pk2(z[2], z[3]); o.z = pk2(z[4], z[5]); o.w = pk2(z[6], z[7]);
            *(GAS v4u*)(G + (size_t)(r0 + i) * D + c) = o;
        }
    }
}

template <int FMT  >
__device__ __forceinline__ void cumsum_table(const float* s1, int n1, const float* s2, int n2, LAS float* tab, LAS float* wsum, int tid) {
    const int lane = tid & 63, wid = tid >> 6;
    float v[5]; float run = 0.f;
#pragma unroll
    for (int j = 0; j < 5; ++j) { const int e = 5 * tid + j; float x = 0.f; if (e < n1) x = s1[(size_t)e * NH]; else if (e < n1 + n2) x = s2[(size_t)(e - n1) * NH]; run += x; v[j] = run; }
    float sc = run;
#pragma unroll
    for (int o = 1; o < 64; o <<= 1) { const float t = __shfl_up(sc, o); if (lane >= o) sc += t; }
    if (lane == 63) wsum[wid] = sc;
    __syncthreads();
    float off = 0.f;
    for (int w = 0; w < wid; ++w) off += wsum[w];
    const float excl = off + sc - run;
#pragma unroll
    for (int j = 0; j < 5; ++j) { const int e = 5 * tid + j; if (e < n1 + n2) { const float bias = -(excl + v[j]) * LOG2E;
        if (FMT == 0) tab[e] = bias;
        else { const unsigned p1 = f2bf(bias); const float r1 = bias - bf2f((unsigned short)p1); const unsigned p2 = f2bf(r1); const float r2 = r1 - bf2f((unsigned short)p2); const unsigned p3 = f2bf(r2);
            ((LAS v4u*)tab)[e] = (v4u){p1 | (p2 << 16), p3 | 0x3F800000u, 0x3F803F80u, 0u}; } } }
    __syncthreads();
}

__device__ __forceinline__ void attn_simple_phase(Frame& F, bool do_prompt) {
    bf16* Qb = ws_bf(F, WS_BIG); const bf16* Kb = ws_bf(F, WS_BIG + SZ_ACT); const bf16* Vb = ws_bf(F, WS_BIG + 2 * SZ_ACT);
    LAS float* tab = (LAS float*)(F.lds + RING_OFF); LAS float* wsum = (LAS float*)(F.lds + RING_OFF + 16384);
    const int lane = F.lane;
    for (int bh = F.vcu >> 1; bh < NB * NH; bh += F.G >> 1) {
        const int b = bh >> 4, h = bh & 15, half = F.vcu & 1;
        __syncthreads();
        if (do_prompt) cumsum_table<0>(F.out + O_LFP + (size_t)b * SEQ * NH + h, SEQ, nullptr, 0, tab, wsum, F.tid);
        for (int i = F.wave; do_prompt && i < 16; i += NWAVES) {
            const int tb = 2 * i + half, t = tb * 64 + lane; const size_t row = (size_t)b * SEQ + t;
            float q[64], o[64];
#pragma unroll
            for (int d = 0; d < 64; d += 8) { float f[8]; unpack8(*(const GAS v4u*)(Qb + row * D + h * HD + d), f);
#pragma unroll
                for (int j = 0; j < 8; ++j) { q[d + j] = f[j]; o[d + j] = 0.f; } }
            float mx = -1e30f, l = 0.f;
            const int kend = tb * 64 + 63;
            for (int k = 0; k <= kend; ++k) {
                const size_t kr = ((size_t)b * SEQ + k) * D + h * HD;
                float s = 0.f;
#pragma unroll
                for (int d = 0; d < 64; d += 8) { float f[8]; unpack8(*(const GAS v4u*)(Kb + kr + d), f);
#pragma unroll
                    for (int j = 0; j < 8; ++j) s += q[d + j] * f[j]; }
                s += tab[k];
                if (k > t) s = -1e30f;
                const float mn = fmaxf(mx, s), al = __builtin_amdgcn_exp2f(mx - mn), p = (k > t) ? 0.f : __builtin_amdgcn_exp2f(s - mn);
                mx = mn; l = l * al + p;
#pragma unroll
                for (int d = 0; d < 64; d += 8) { float f[8]; unpack8(*(const GAS v4u*)(Vb + kr + d), f);
#pragma unroll
                    for (int j = 0; j < 8; ++j) o[d + j] = o[d + j] * al + p * f[j]; }
            }
            const float il = 1.0f / l;
#pragma unroll
            for (int d = 0; d < 64; d += 8) { v4u w; w.x = pk2(o[d] * il, o[d + 1] * il); w.y = pk2(o[d + 2] * il, o[d + 3] * il); w.z = pk2(o[d + 4] * il, o[d + 5] * il); w.w = pk2(o[d + 6] * il, o[d + 7] * il);
                *(GAS v4u*)(Qb + row * D + h * HD + d) = w; }
        }
        if (half == 0) {
            __syncthreads();
            cumsum_table<0>(F.cache_lf + (size_t)b * PAST * NH + h, PAST, F.out + O_LFS + (size_t)b * DSEQ * NH + h, DSEQ, tab, wsum, F.tid);
            if (F.wave == 0) {
                const int t = lane; const size_t row = (size_t)MP + (size_t)b * DSEQ + t;
                float q[64], o[64];
#pragma unroll
                for (int d = 0; d < 64; d += 8) { float f[8]; unpack8(*(const GAS v4u*)(Qb + row * D + h * HD + d), f);
#pragma unroll
                    for (int j = 0; j < 8; ++j) { q[d + j] = f[j]; o[d + j] = 0.f; } }
                float mx = -1e30f, l = 0.f;
                for (int k = 0; k < PAST; ++k) {
                    const float* kp = F.cache_k + (((size_t)b * PAST + k) * NH + h) * HD; const float* vp = F.cache_v + (((size_t)b * PAST + k) * NH + h) * HD;
                    float s = 0.f;
#pragma unroll
                    for (int d = 0; d < 64; d += 4) { const pg8::f32x4 f = *(const GAS pg8::f32x4*)(kp + d); s += q[d] * f[0] + q[d + 1] * f[1] + q[d + 2] * f[2] + q[d + 3] * f[3]; }
                    s += tab[k];
                    const float mn = fmaxf(mx, s), al = __builtin_amdgcn_exp2f(mx - mn), p = __builtin_amdgcn_exp2f(s - mn);
                    mx = mn; l = l * al + p;
#pragma unroll
                    for (int d = 0; d < 64; d += 4) { const pg8::f32x4 f = *(const GAS pg8::f32x4*)(vp + d); o[d] = o[d] * al + p * f[0]; o[d + 1] = o[d + 1] * al + p * f[1]; o[d + 2] = o[d + 2] * al + p * f[2]; o[d + 3] = o[d + 3] * al + p * f[3]; }
                }
                for (int k = 0; k < DSEQ; ++k) {
                    const size_t kr = ((size_t)MP + (size_t)b * DSEQ + k) * D + h * HD;
                    float s = 0.f;
#pragma unroll
                    for (int d = 0; d < 64; d += 8) { float f[8]; unpack8(*(const GAS v4u*)(Kb + kr + d), f);
#pragma unroll
                        for (int j = 0; j < 8; ++j) s += q[d + j] * f[j]; }
                    s += tab[PAST + k];
                    if (k > t) s = -1e30f;
                    const float mn = fmaxf(mx, s), al = __builtin_amdgcn_exp2f(mx - mn), p = (k > t) ? 0.f : __builtin_amdgcn_exp2f(s - mn);
                    mx = mn; l = l * al + p;
#pragma unroll
                    for (int d = 0; d < 64; d += 8) { float f[8]; unpack8(*(const GAS v4u*)(Vb + kr + d), f);
#pragma unroll
                        for (int j = 0; j < 8; ++j) o[d + j] = o[d + j] * al + p * f[j]; }
                }
                const float il = 1.0f / l;
#pragma unroll
                for (int d = 0; d < 64; d += 8) { v4u w; w.x = pk2(o[d] * il, o[d + 1] * il); w.y = pk2(o[d + 2] * il, o[d + 3] * il); w.z = pk2(o[d + 4] * il, o[d + 5] * il); w.w = pk2(o[d + 6] * il, o[d + 7] * il);
                    *(GAS v4u*)(Qb + row * D + h * HD + d) = w; }
            }
        }
    }
    __syncthreads();
}

__device__ __forceinline__ void attn_fast_phase(Frame& F, unsigned char* lds_generic) {
    constexpr int BT_OFF = 86016, ZB_OFF = BT_OFF + 32768, WS_OFF = ZB_OFF + 1024;
    static_assert(attn_body::ATTN_LDS_BYTES <= BT_OFF && WS_OFF + 64 <= RING_BYTES, "attention LDS map");
    const attn_body::AttnTensors AT{(const attn_body::bf16*)ws_bf(F, WS_BIG), (const attn_body::bf16*)ws_bf(F, WS_BIG + SZ_ACT), (const attn_body::bf16*)ws_bf(F, WS_BIG + 2 * SZ_ACT), (attn_body::bf16*)ws_bf(F, WS_BIG)};
    for (int v = F.vcu; v < 2 * NB * NH; v += F.G) {
        const int bh = v >> 1, b = bh >> 4, h = bh & 15;
        __syncthreads();
        if (F.tid < 256) ((LAS unsigned*)(F.lds + ZB_OFF))[F.tid] = 0u;
        cumsum_table<1>(F.out + O_LFP + (size_t)b * SEQ * NH + h, SEQ, nullptr, 0, (LAS float*)(F.lds + BT_OFF), (LAS float*)(F.lds + WS_OFF), F.tid);
        const attn_body::StaticOrder S(v);
        attn_body::attn_phase<attn_body::StaticOrder>((char*)lds_generic + RING_OFF, AT, S, (attn_body::lds_cptr)(F.lds + BT_OFF), (attn_body::lds_cptr)(F.lds + ZB_OFF));
    }
}

typedef float sa_f32x16 __attribute__((ext_vector_type(16)));
__device__ __forceinline__ int sa_crow(int r, int hi) { return (r & 3) + 8 * (r >> 2) + 4 * hi; }
__device__ __forceinline__ unsigned sa_pk(float lo, float hi) { return pg8::cvt_pk_bf16(lo, hi); }
__device__ __forceinline__ void sa_tile(sa_f32x16& o0, sa_f32x16& o1, float& m, float& l, const pg8::bf16x8 (&qf)[4], const pg8::bf16x8 (&kf)[4], const pg8::bf16x8 (&vf)[2][2],
                                        const LAS float* tabk, int hi, int tq, int kn0) {
    sa_f32x16 p = {};
#pragma unroll
    for (int s = 0; s < 4; ++s) p = __builtin_amdgcn_mfma_f32_32x32x16_bf16(kf[s], qf[s], p, 0, 0, 0);
#pragma unroll
    for (int g = 0; g < 4; ++g) { const pg8::f32x4 bb = *(const LAS pg8::f32x4*)(tabk + 8 * g + 4 * hi);
#pragma unroll
        for (int j = 0; j < 4; ++j) p[4 * g + j] += bb[j]; }
    if (kn0 >= 0) {
#pragma unroll
        for (int r = 0; r < 16; ++r) if (kn0 + sa_crow(r, hi) > tq) p[r] = -1e30f;
    }
    float rm = p[0];
#pragma unroll
    for (int r = 1; r < 16; ++r) rm = fmaxf(rm, p[r]);
    rm = fmaxf(rm, __shfl_xor(rm, 32));
    const float mn = fmaxf(m, rm), al = __builtin_amdgcn_exp2f(m - mn);
    m = mn;
    float ls = 0.f;
#pragma unroll
    for (int r = 0; r < 16; ++r) { p[r] = __builtin_amdgcn_exp2f(p[r] - mn); ls += p[r]; }
    l = l * al + ls;
#pragma unroll
    for (int r = 0; r < 16; ++r) { o0[r] *= al; o1[r] *= al; }
    pg8::u32x4 w0, w1;
    w0.x = sa_pk(p[0], p[1]); w0.y = sa_pk(p[2], p[3]); w0.z = sa_pk(p[4], p[5]); w0.w = sa_pk(p[6], p[7]);
    w1.x = sa_pk(p[8], p[9]); w1.y = sa_pk(p[10], p[11]); w1.z = sa_pk(p[12], p[13]); w1.w = sa_pk(p[14], p[15]);
    const pg8::bf16x8 pf0 = __builtin_bit_cast(pg8::bf16x8, w0), pf1 = __builtin_bit_cast(pg8::bf16x8, w1);
    o0 = __builtin_amdgcn_mfma_f32_32x32x16_bf16(vf[0][0], pf0, o0, 0, 0, 0); o1 = __builtin_amdgcn_mfma_f32_32x32x16_bf16(vf[0][1], pf0, o1, 0, 0, 0);
    o0 = __builtin_amdgcn_mfma_f32_32x32x16_bf16(vf[1][0], pf1, o0, 0, 0, 0); o1 = __builtin_amdgcn_mfma_f32_32x32x16_bf16(vf[1][1], pf1, o1, 0, 0, 0);
}
__device__ __forceinline__ void attn_sample_fast(Frame& F) {
    constexpr int OW_OFF = 0, ML_OFF = 65536, TAB_OFF = ML_OFF + 2048, WS_OFF = TAB_OFF + 8704;
    static_assert(WS_OFF + 64 <= RING_BYTES, "decode attention LDS map");
    bf16* Qb = ws_bf(F, WS_BIG); const bf16* Kb = ws_bf(F, WS_BIG + SZ_ACT); const bf16* Vb = ws_bf(F, WS_BIG + 2 * SZ_ACT);
    const int lane = F.lane, r32 = lane & 31, hi = lane >> 5, w = F.wave;
    LAS float* tab = (LAS float*)(F.lds + TAB_OFF);
    LAS float* ow = (LAS float*)(F.lds + OW_OFF);
    LAS float* mw = (LAS float*)(F.lds + ML_OFF);
    for (int v = F.vcu; v < 2 * NB * NH; v += F.G) {
        const int bh = v >> 1, qblk = v & 1, b = bh >> 4, h = bh & 15;
        __syncthreads();
        cumsum_table<0>(F.cache_lf + (size_t)b * PAST * NH + h, PAST, F.out + O_LFS + (size_t)b * DSEQ * NH + h, DSEQ, tab, (LAS float*)(F.lds + WS_OFF), F.tid);
        const size_t srow0 = (size_t)MP + (size_t)b * DSEQ;
        pg8::bf16x8 qf[4];
#pragma unroll
        for (int s = 0; s < 4; ++s) qf[s] = *(const pg8::bf16x8*)(Qb + (srow0 + 32 * qblk + r32) * D + h * HD + 16 * s + 8 * hi);
        sa_f32x16 o0 = {}, o1 = {}; float m = -1e30f, l = 0.f;
        const float* kbase = F.cache_k + (((size_t)b * PAST + r32) * NH + h) * HD + 8 * hi;
        const float* vbase = F.cache_v + (((size_t)b * PAST + 4 * hi) * NH + h) * HD + r32;
        pg8::f32x4 kr[4][2]; float vr[2][2][8];
        { const int key0 = 32 * (8 * w);
#pragma unroll
          for (int s = 0; s < 4; ++s) { kr[s][0] = *(const GAS pg8::f32x4*)(kbase + (size_t)key0 * D + 16 * s); kr[s][1] = *(const GAS pg8::f32x4*)(kbase + (size_t)key0 * D + 16 * s + 4); }
#pragma unroll
          for (int s = 0; s < 2; ++s)
#pragma unroll
            for (int j = 0; j < 8; ++j) { const float* vp = vbase + (size_t)(key0 + 16 * s + 8 * (j >> 2) + (j & 3)) * D; vr[s][0][j] = vp[0]; vr[s][1][j] = vp[32]; } }
        for (int i = 0; i < 8; ++i) {
            const int key0 = 32 * (8 * w + i);
            pg8::bf16x8 kf[4], vf[2][2];
#pragma unroll
            for (int s = 0; s < 4; ++s) { pg8::u32x4 t; t.x = sa_pk(kr[s][0][0], kr[s][0][1]); t.y = sa_pk(kr[s][0][2], kr[s][0][3]); t.z = sa_pk(kr[s][1][0], kr[s][1][1]); t.w = sa_pk(kr[s][1][2], kr[s][1][3]); kf[s] = __builtin_bit_cast(pg8::bf16x8, t); }
#pragma unroll
            for (int s = 0; s < 2; ++s)
#pragma unroll
                for (int d = 0; d < 2; ++d) { pg8::u32x4 t; t.x = sa_pk(vr[s][d][0], vr[s][d][1]); t.y = sa_pk(vr[s][d][2], vr[s][d][3]); t.z = sa_pk(vr[s][d][4], vr[s][d][5]); t.w = sa_pk(vr[s][d][6], vr[s][d][7]); vf[s][d] = __builtin_bit_cast(pg8::bf16x8, t); }
            if (i + 1 < 8) { const int kn = key0 + 32;
#pragma unroll
                for (int s = 0; s < 4; ++s) { kr[s][0] = *(const GAS pg8::f32x4*)(kbase + (size_t)kn * D + 16 * s); kr[s][1] = *(const GAS pg8::f32x4*)(kbase + (size_t)kn * D + 16 * s + 4); }
#pragma unroll
                for (int s = 0; s < 2; ++s)
#pragma unroll
                    for (int j = 0; j < 8; ++j) { const float* vp = vbase + (size_t)(kn + 16 * s + 8 * (j >> 2) + (j & 3)) * D; vr[s][0][j] = vp[0]; vr[s][1][j] = vp[32]; } }
            sa_tile(o0, o1, m, l, qf, kf, vf, tab + key0, hi, 0, -1);
        }
        if (w <= qblk) {
            const int nt = w; pg8::bf16x8 kf[4], vf[2][2];
#pragma unroll
            for (int s = 0; s < 4; ++s) kf[s] = *(const pg8::bf16x8*)(Kb + (srow0 + 32 * nt + r32) * D + h * HD + 16 * s + 8 * hi);
#pragma unroll
            for (int s = 0; s < 2; ++s)
#pragma unroll
                for (int d = 0; d < 2; ++d) { unsigned short e[8];
#pragma unroll
                    for (int j = 0; j < 8; ++j) e[j] = Vb[(srow0 + 32 * nt + 16 * s + 8 * (j >> 2) + 4 * hi + (j & 3)) * D + h * HD + 32 * d + r32];
                    pg8::u32x4 t; t.x = e[0] | ((unsigned)e[1] << 16); t.y = e[2] | ((unsigned)e[3] << 16); t.z = e[4] | ((unsigned)e[5] << 16); t.w = e[6] | ((unsigned)e[7] << 16); vf[s][d] = __builtin_bit_cast(pg8::bf16x8, t); }
            sa_tile(o0, o1, m, l, qf, kf, vf, tab + PAST + 32 * nt, hi, 32 * qblk + r32, 32 * nt);
        }
        l += __shfl_xor(l, 32);
        if (hi == 0) { mw[w * 32 + r32] = m; mw[256 + w * 32 + r32] = l; }
#pragma unroll
        for (int r = 0; r < 16; ++r) { const int d = sa_crow(r, hi); ow[(w * 64 + d) * 32 + r32] = o0[r]; ow[(w * 64 + 32 + d) * 32 + r32] = o1[r]; }
        __syncthreads();
        { const int q = F.tid & 31, d0 = (F.tid >> 5) * 4;
          float mm = mw[q]; float sc[8];
#pragma unroll
          for (int ww = 1; ww < 8; ++ww) mm = fmaxf(mm, mw[ww * 32 + q]);
          float L = 0.f;
#pragma unroll
          for (int ww = 0; ww < 8; ++ww) { sc[ww] = __builtin_amdgcn_exp2f(mw[ww * 32 + q] - mm); L += mw[256 + ww * 32 + q] * sc[ww]; }
          const float il = 1.0f / L; float acc[4] = {0.f, 0.f, 0.f, 0.f};
#pragma unroll
          for (int ww = 0; ww < 8; ++ww)
#pragma unroll
              for (int dd = 0; dd < 4; ++dd) acc[dd] += ow[(ww * 64 + d0 + dd) * 32 + q] * sc[ww];
          v2u o; o.x = pk2(acc[0] * il, acc[1] * il); o.y = pk2(acc[2] * il, acc[3] * il);
          *(GAS v2u*)(Qb + (srow0 + 32 * qblk + q) * D + h * HD + d0) = o; }
    }
    __syncthreads();
}

template <class Epi, class Sched>
__device__ __forceinline__ void run_gemm(Frame& F, const pg8::Gemm& g, const Sched& S, const Epi& E) {
#if MK_FAST_GEMM
    pg8::gemm_phase<Epi, Sched, Epi::AFTER_DRAIN ? false : PG8_ALIGN, PG8_SP2>(F.lds + RING_OFF, g, S, E);
#else
    mk::gemm_phase_simple<Epi, Sched>(F.lds + RING_OFF, g, S, E);
#endif
}
__device__ __forceinline__ void out_proj_phase(Frame& F, const bf16* A, const bf16* Bt, int K, const float* base_p, const float* base_s, float scale) {
    float* X = F.out + O_Y;
    pg8::Gemm g{A, Bt, M, D, K};
    mk::EpiRes E{base_p, base_s, X, ws_bf(F, WS_XB), (float*)(F.ws + WS_RS), scale};
    const int nunits = (M / 256) * (D / 256);
    for (int rnd = 0; rnd * F.G < nunits; ++rnd) {
        mk::RoundOrder S; S.init(M, D, F.G, (int)blockIdx.x); S.rnd = rnd;
        run_gemm(F, g, S, E);
        __syncthreads();
    }
}
__device__ __forceinline__ void ffn_in_phase(Frame& F, int w) {
    pg8::Gemm g{ws_bf(F, WS_XB), ws_bf(F, WS_FFI + (size_t)w * SZ_FFI), M, 2 * FF, D};
    pg8::StaticOrder S; S.init(M, 2 * FF, F.G, (int)blockIdx.x);
    mk::EpiSwiglu E{ws_bf(F, WS_H), (const float*)(F.ws + WS_RS)};
    run_gemm(F, g, S, E);
}

struct Args { const float* in[18]; float* out; unsigned char* ws; int ph_lo, ph_hi; };
__global__ void __launch_bounds__(NWAVES * 64, 2) mk_fwd(Args args) {
    extern __shared__ __attribute__((aligned(16))) unsigned char lds[];
    Frame F;
    F.lds = (LAS unsigned char*)lds;
    F.MISC = (volatile LAS unsigned*)(F.lds + MISC_OFF);
    F.tid = threadIdx.x; F.lane = F.tid & 63; F.wave = __builtin_amdgcn_readfirstlane(F.tid >> 6);
    F.G = gridDim.x; { const int bx = blockIdx.x; F.vcu = (F.G % 8 == 0) ? (bx % 8) * (F.G / 8) + bx / 8 : bx; }
    F.ws = args.ws; F.out = args.out; F.ctl = (gu32*)(args.ws + WS_CTL);
    F.x_p = args.in[0]; F.x_s = args.in[1]; F.state_conv = args.in[2]; F.cache_k = args.in[3]; F.cache_v = args.in[4]; F.cache_lf = args.in[5];
    F.norm_ffn = args.in[6]; F.ffn_w_in = args.in[7]; F.ffn_w_out = args.in[8]; F.norm_mix = args.in[9]; F.conv_w_in = args.in[10]; F.conv_w = args.in[11];
    F.conv_w_out = args.in[12]; F.attn_w_in = args.in[13]; F.attn_bf = args.in[14]; F.q_norm = args.in[15]; F.k_norm = args.in[16]; F.attn_w_out = args.in[17];
    for (int u = F.tid; u < (LDS_BYTES - LDSCTL_OFF) / 4; u += NWAVES * 64) ((LAS unsigned*)(F.lds + LDSCTL_OFF))[u] = 0u;
    __syncthreads();
#if MK_ONE_LAUNCH
    XcdBarrier bar = xcd_barrier_post((unsigned*)(F.ctl + CW_BAR), F.MISC + 8);
#define GRID_BAR() xcd_barrier(bar)
#else
#define GRID_BAR() do {} while (0)
#endif
    const int lo = args.ph_lo, hi = args.ph_hi;
#define IN(k) (lo <= (k) && (k) < hi)
#define SEAM(k) do { if (IN(k) && IN((k) + 1)) GRID_BAR(); } while (0)
    float* X = F.out + O_Y;
    const float* Xs = X + (size_t)MP * D;

    if (IN(0)) { p0_prologue(F); VM_WAIT(); __syncthreads(); } SEAM(0);
    if (IN(1)) ffn_in_phase(F, 0); SEAM(1);
    if (IN(2)) out_proj_phase(F, ws_bf(F, WS_H), ws_bf(F, WS_FFO + 0 * SZ_FFO), FF, F.x_p, F.x_s, 0.5f); SEAM(2);
    if (IN(3)) {
        pg8::Gemm g{ws_bf(F, WS_XB), ws_bf(F, WS_CI), M, 3 * D, D};
        pg8::StaticOrder S; S.init(M, 3 * D, F.G, (int)blockIdx.x);
        mk::EpiConvIn E{ws_bf(F, WS_BIG), ws_bf(F, WS_BIG + SZ_ACT), (const float*)(F.ws + WS_RS), F.out + O_CSP, F.out + O_CSS};
        run_gemm(F, g, S, E);
    } SEAM(3);
    if (IN(4)) conv_ew_phase(F); SEAM(4);
    if (IN(5)) out_proj_phase(F, ws_bf(F, WS_BIG), ws_bf(F, WS_CO), D, X, Xs, 1.0f); SEAM(5);
    if (IN(6)) ffn_in_phase(F, 1); SEAM(6);
    if (IN(7)) out_proj_phase(F, ws_bf(F, WS_H), ws_bf(F, WS_FFO + 1 * SZ_FFO), FF, X, Xs, 0.5f); SEAM(7);
    if (IN(8)) ffn_in_phase(F, 2); SEAM(8);
    if (IN(9)) out_proj_phase(F, ws_bf(F, WS_H), ws_bf(F, WS_FFO + 2 * SZ_FFO), FF, X, Xs, 0.5f); SEAM(9);
    if (IN(10)) {
        pg8::Gemm g{ws_bf(F, WS_XB), ws_bf(F, WS_AI), M, NAI, D};
        pg8::StaticOrder S; S.init(M, NAI, F.G, (int)blockIdx.x);
        mk::EpiAttnIn E{ws_bf(F, WS_BIG), ws_bf(F, WS_BIG + SZ_ACT), ws_bf(F, WS_BIG + 2 * SZ_ACT), (const float*)(F.ws + WS_RS), F.q_norm, F.k_norm, F.attn_bf,
                        F.out + O_KP, F.out + O_KS, F.out + O_VP, F.out + O_VS, F.out + O_LFP, F.out + O_LFS};
        run_gemm(F, g, S, E);
    } SEAM(10);
#if MK_FAST_ATTN
    if (IN(11)) { attn_fast_phase(F, lds); attn_sample_fast(F); } SEAM(11);
#else
    if (IN(11)) { attn_simple_phase(F, true); } SEAM(11);
#endif
    if (IN(12)) out_proj_phase(F, ws_bf(F, WS_BIG), ws_bf(F, WS_AO), D, X, Xs, 1.0f); SEAM(12);
    if (IN(13)) ffn_in_phase(F, 3); SEAM(13);
    if (IN(14)) out_proj_phase(F, ws_bf(F, WS_H), ws_bf(F, WS_FFO + 3 * SZ_FFO), FF, X, Xs, 0.5f);
#undef IN
#undef SEAM
}

extern "C" void kernel_launch(void* const* d_in, const int* in_sizes, int n_in, void* d_out, int out_size, void* d_ws, size_t ws_size, hipStream_t stream) {
    static int grid = 0;
    if (grid == 0) {
        if (n_in != 18 || in_sizes[0] != MP * D || (size_t)out_size != O_END || ws_size < WS_END) {
            fprintf(stderr, "kernel_launch: unexpected problem: n_in %d in0 %d out %d ws %zu; nothing launched\n", n_in, n_in > 0 ? in_sizes[0] : -1, out_size, ws_size); grid = -1; return; }
        int dev = 0, cus = 0, per_cu = 0;
        if (hipGetDevice(&dev) != hipSuccess || hipDeviceGetAttribute(&cus, hipDeviceAttributeMultiprocessorCount, dev) != hipSuccess) { grid = -1; return; }
        if (hipFuncSetAttribute((const void*)mk_fwd, hipFuncAttributeMaxDynamicSharedMemorySize, LDS_BYTES) != hipSuccess) { fprintf(stderr, "kernel_launch: hipFuncSetAttribute failed\n"); grid = -1; return; }
        if (hipOccupancyMaxActiveBlocksPerMultiprocessor(&per_cu, (const void*)mk_fwd, NWAVES * 64, LDS_BYTES) != hipSuccess || per_cu < 1)
            fprintf(stderr, "kernel_launch: note: occupancy query reports %d workgroups per CU\n", per_cu);
        (void)hipGetLastError();
        grid = cus;
    }
    if (grid < 0) return;
    if (hipMemsetAsync((char*)d_ws + WS_CTL, 0, CTL_ZERO_BYTES, stream) != hipSuccess) return;
    Args a{};
    for (int i = 0; i < 18; ++i) a.in[i] = (const float*)d_in[i];
    a.out = (float*)d_out; a.ws = (unsigned char*)d_ws;
#if MK_ONE_LAUNCH
    a.ph_lo = 0; a.ph_hi = NPH;
    hipLaunchKernelGGL(mk_fwd, dim3(grid), dim3(NWAVES * 64), LDS_BYTES, stream, a);
#else
    for (int p = 0; p < NPH; ++p) { a.ph_lo = p; a.ph_hi = p + 1; hipLaunchKernelGGL(mk_fwd, dim3(grid), dim3(NWAVES * 64), LDS_BYTES, stream, a); }
#endif
}
```

```cpp
#include <hip/hip_runtime.h>
#include <hip/hip_bf16.h>
#include <cstdio>
#include <cstdint>
#include <cmath>

#ifndef MK_ONE_LAUNCH
#define MK_ONE_LAUNCH 1
#endif
#ifndef MK_FAST_GEMM
#define MK_FAST_GEMM 1
#endif
#ifndef MK_FAST_ATTN
#define MK_FAST_ATTN 1
#endif

#ifndef MK_PROBE
#define MK_PROBE -1
#endif
#ifndef MK_PROBE_REPS
#define MK_PROBE_REPS 0
#endif

constexpr int D = 1024, NH = 16, HD = 64, FF = 2816, SEQ = 2048, NB = 8, DSEQ = 64, PAST = 2048;
constexpr int MP = NB * SEQ, MS = NB * DSEQ, M = MP + MS;
constexpr int NAI = 3328;
constexpr float NORM_EPS = 1e-6f, LOG2E = 1.4426950408889634f;
constexpr float QSCALE = 0.125f * LOG2E;

constexpr size_t O_Y = 0;
constexpr size_t O_CSP = (size_t)M * D;
constexpr size_t O_CSS = O_CSP + (size_t)NB * 2 * D;
constexpr size_t O_KP = O_CSS + (size_t)NB * 2 * D;
constexpr size_t O_VP = O_KP + (size_t)MP * D;
constexpr size_t O_LFP = O_VP + (size_t)MP * D;
constexpr size_t O_KS = O_LFP + (size_t)MP * NH;
constexpr size_t O_VS = O_KS + (size_t)MS * D;
constexpr size_t O_LFS = O_VS + (size_t)MS * D;
constexpr size_t O_END = O_LFS + (size_t)MS * NH;

constexpr size_t MiB = 1u << 20;
constexpr size_t WS_CTL = 0, CTL_ZERO_BYTES = 1 * MiB;
constexpr size_t SZ_FFI = (size_t)2 * FF * D * 2, SZ_FFO = (size_t)D * FF * 2;
constexpr size_t WS_FFI = 1 * MiB;
constexpr size_t WS_FFO = WS_FFI + 4 * SZ_FFI;
constexpr size_t WS_CI = WS_FFO + 4 * SZ_FFO;
constexpr size_t WS_CO = WS_CI + (size_t)3 * D * D * 2;
constexpr size_t WS_AI = WS_CO + (size_t)D * D * 2;
constexpr size_t WS_AO = WS_AI + (size_t)NAI * D * 2;
constexpr size_t WS_XB = WS_AO + (size_t)D * D * 2;
constexpr size_t WS_RS = WS_XB + (size_t)M * D * 2;
constexpr size_t WS_BIG = ((WS_RS + (size_t)MP * 16 + (size_t)MS * 64 + MiB - 1) / MiB) * MiB;
constexpr size_t SZ_ACT = (size_t)M * D * 2;
constexpr size_t WS_H = WS_BIG;
constexpr size_t WS_END = WS_BIG + 3 * SZ_ACT;
static_assert(WS_END <= 256 * MiB && (size_t)M * FF * 2 <= 3 * SZ_ACT, "d_ws map");
constexpr int CW_TMO = 0, CW_CODE = 1, CW_BAR = 4096;

constexpr int RING_OFF = 0, RING_BYTES = 131072, LDSCTL_OFF = RING_BYTES, MISC_OFF = LDSCTL_OFF + 320, LDS_BYTES = 147456;
constexpr int NWAVES = 8;
constexpr int NPH = 15;

#define GAS __attribute__((address_space(1)))
#define LAS __attribute__((address_space(3)))
typedef unsigned short bf16;
typedef unsigned v4u __attribute__((ext_vector_type(4)));
typedef unsigned v2u __attribute__((ext_vector_type(2)));
typedef GAS unsigned gu32;
#define RLX_AGENT __ATOMIC_RELAXED, __HIP_MEMORY_SCOPE_AGENT
#define LDS_WAIT() asm volatile("s_waitcnt lgkmcnt(0)" ::: "memory")
#define VM_WAIT() asm volatile("s_waitcnt vmcnt(0)" ::: "memory")
__device__ __forceinline__ unsigned f2bf(float f) { unsigned u = __builtin_bit_cast(unsigned, f); return (u + 0x7fffu + ((u >> 16) & 1u)) >> 16; }
__device__ __forceinline__ unsigned pk2(float lo, float hi) { return f2bf(lo) | (f2bf(hi) << 16); }
__device__ __forceinline__ float bf2f(unsigned short h) { return __builtin_bit_cast(float, (unsigned)h << 16); }
__device__ __forceinline__ float bflo(unsigned w) { return __builtin_bit_cast(float, w << 16); }
__device__ __forceinline__ float bfhi(unsigned w) { return __builtin_bit_cast(float, w & 0xffff0000u); }

namespace pg8 {
#define PG8_LAS __attribute__((address_space(3)))
typedef unsigned short bf16_t;
typedef short bf16x8 __attribute__((ext_vector_type(8)));
typedef float f32x4 __attribute__((ext_vector_type(4)));
typedef unsigned u32x4 __attribute__((ext_vector_type(4)));
constexpr int BM = 256, BK = 64, HALF = 128, HTB = HALF * BK * 2  , STAGE_BYTES = 8 * HTB, NXCD = 8, WGM = 8;

__host__ __device__ __forceinline__ int lds_byte(int r, int c) { const int st = (r >> 4) * 2 + (c >> 5), rr = r & 15, cc = c & 31, ob = rr * 64 + cc * 2; return st * 1024 + (ob ^ (((ob >> 9) & 1) << 5)); }
__host__ __device__ __forceinline__ void stage_rc(int b, int& R, int& C) { const int st = b / 1024, sb = b % 1024, swz = sb ^ (((sb >> 9) & 1) << 5); R = (st >> 1) * 16 + swz / 64; C = (st & 1) * 32 + (swz % 64) / 2; }
__host__ __device__ __forceinline__ int perm32(int rho) { const int n = rho >> 4, i = rho & 15; return 8 * (i >> 2) + 4 * n + (i & 3); }

struct Unit { int pm, pn; };
struct Gemm { const bf16_t* A; const bf16_t* Bt; int M, N, K; };

struct StaticOrder {
    int nM, nN, nwg, G, c;
    __host__ __device__ void init(int M, int N, int G_, int c_) { nM = M / BM; nN = N / BM; nwg = nM * nN; G = G_; c = c_; }
    __host__ __device__ bool next(int i, Unit& u) const {
        const long L = (long)i * G + c; if (L >= nwg) return false;
        int wgid = (int)L; { const int q = nwg / NXCD, r = nwg % NXCD, xcd = wgid % NXCD, off = wgid / NXCD; wgid = (xcd < r ? xcd * (q + 1) : r * (q + 1) + (xcd - r) * q) + off; }
        const int nig = WGM * nN, gid = wgid / nig, fm = gid * WGM, gsz = (nM - fm) < WGM ? (nM - fm) : WGM;
        u.pm = fm + ((wgid % nig) % gsz); u.pn = (wgid % nig) / gsz; return true;
    }
    __device__ __forceinline__ void a_ready(const Unit&) const {}
    __device__ __forceinline__ void done(const Unit&) const {}
};

__device__ __forceinline__ unsigned cvt_pk_bf16(float lo, float hi) { unsigned r; asm volatile("v_cvt_pk_bf16_f32 %0, %1, %2" : "=v"(r) : "v"(lo), "v"(hi)); return r; }
template <class Epi, class Sched, bool ALIGN_EPI = false, bool SP2 = false>
__device__ __forceinline__ void gemm_phase(PG8_LAS unsigned char* lds, const Gemm g, const Sched& S, const Epi& E) {
    int tid = threadIdx.x; asm volatile("" : "+v"(tid));
    const int wid = __builtin_amdgcn_readfirstlane(tid >> 6), lane = tid & 63, wr = wid >> 2, wc = wid & 3, fr = lane & 15, fq = lane >> 4;
    const int K = g.K, nt = K / BK;
    unsigned voffA[2], voffB[2];
#pragma unroll
    for (int i = 0; i < 2; ++i) { int R, C; stage_rc(tid * 16 + i * 8192, R, C); const int Rb = Epi::PERM ? ((R & ~31) + perm32(R & 31)) : R;
        voffA[i] = (unsigned)(R * K + C) * 2u; voffB[i] = (unsigned)(Rb * K + C) * 2u; }
    const size_t kstep = (size_t)(BK * 2);
    const size_t hstep = (size_t)HALF * K * 2;
    const size_t tstep = 2 * hstep;
    const unsigned ldsw = (unsigned)wid * 1024u;
    const int aoff = lds_byte(wr * 64 + fr, fq * 8), boff = lds_byte(wc * 32 + fr, fq * 8);
#define PG8_SA(b, h) (((b) * 2 + (h)) * HTB)
#define PG8_SB(b, h) ((4 + (b) * 2 + (h)) * HTB)
#define PG8_STAGE(bufoff, gbase, voff) do { _Pragma("unroll") for (int _i = 0; _i < 2; ++_i) \
        __builtin_amdgcn_global_load_lds((const unsigned*)((const char*)(gbase) + (voff)[_i]), (PG8_LAS unsigned*)(lds + (bufoff) + ldsw + _i * 8192), 16, 0, 0); } while (0)
#define PG8_LDA(dst, b, h) do { _Pragma("unroll") for (int m = 0; m < 4; ++m) _Pragma("unroll") for (int k = 0; k < 2; ++k) dst[m][k] = *(const PG8_LAS bf16x8*)(lds + PG8_SA(b, h) + aoff + m * 2048 + k * 1024); } while (0)
#define PG8_LDB(dst, b, h) do { _Pragma("unroll") for (int n = 0; n < 2; ++n) _Pragma("unroll") for (int k = 0; k < 2; ++k) dst[n][k] = *(const PG8_LAS bf16x8*)(lds + PG8_SB(b, h) + boff + n * 2048 + k * 1024); } while (0)
#define PG8_MMA(ai, bj, At, Bt) do { __builtin_amdgcn_s_setprio(1); _Pragma("unroll") for (int m = 0; m < 4; ++m) _Pragma("unroll") for (int n = 0; n < 2; ++n) _Pragma("unroll") for (int k = 0; k < 2; ++k) \
        acc[ai][bj][m][n] = __builtin_amdgcn_mfma_f32_16x16x32_bf16(Bt[n][k], At[m][k], acc[ai][bj][m][n], 0, 0, 0); __builtin_amdgcn_s_setprio(0); } while (0)
#define PG8_WAIT_V(n) asm volatile("s_waitcnt vmcnt(" #n ")" ::: "memory")
#define PG8_WAIT_L(n) asm volatile("s_waitcnt lgkmcnt(" #n ")" ::: "memory")
#define PG8_BAR __builtin_amdgcn_s_barrier()
#define PG8_SCHED __builtin_amdgcn_sched_barrier(0)
    Unit cur, nxt; int ui = 0;
    if (!S.next(0, cur)) return;
    f32x4 acc[2][2][4][2];
#pragma unroll
    for (int a = 0; a < 2; ++a)
#pragma unroll
        for (int b = 0; b < 2; ++b)
#pragma unroll
            for (int m = 0; m < 4; ++m)
#pragma unroll
                for (int n = 0; n < 2; ++n) acc[a][b][m][n] = (f32x4){0.f, 0.f, 0.f, 0.f};
    bf16x8 At[4][2], B0[2][2], B1[2][2];
    const char* cA = (const char*)g.A + (size_t)cur.pm * tstep; const char* cB = (const char*)g.Bt + (size_t)cur.pn * tstep;
    S.a_ready(cur);
    if constexpr (SP2) {
        PG8_STAGE(PG8_SB(0, 0), cB, voffB); PG8_STAGE(PG8_SB(0, 1), cB + hstep, voffB); PG8_STAGE(PG8_SA(0, 0), cA, voffA); PG8_STAGE(PG8_SA(0, 1), cA + hstep, voffA);
        if (wr == 1) PG8_BAR;
        PG8_WAIT_V(2); PG8_BAR;
        PG8_STAGE(PG8_SB(1, 0), cB + kstep, voffB); PG8_STAGE(PG8_SA(1, 0), cA + kstep, voffA); PG8_STAGE(PG8_SB(1, 1), cB + hstep + kstep, voffB);
        PG8_WAIT_V(6); PG8_BAR;
    } else {
        PG8_STAGE(PG8_SB(0, 0), cB, voffB); PG8_STAGE(PG8_SA(0, 0), cA, voffA); PG8_STAGE(PG8_SB(0, 1), cB + hstep, voffB); PG8_STAGE(PG8_SA(0, 1), cA + hstep, voffA);
        if (wr == 1) PG8_BAR;
        PG8_WAIT_V(4); PG8_BAR;
        PG8_STAGE(PG8_SB(1, 0), cB + kstep, voffB); PG8_STAGE(PG8_SA(1, 0), cA + kstep, voffA); PG8_STAGE(PG8_SB(1, 1), cB + hstep + kstep, voffB);
        PG8_WAIT_V(6); PG8_BAR;
    }
    for (;;) {
        const bool has_next = S.next(ui + 1, nxt);
        const char* nA = has_next ? (const char*)g.A + (size_t)nxt.pm * tstep : cA; const char* nB = has_next ? (const char*)g.Bt + (size_t)nxt.pn * tstep : cB;
        for (int t = 0; t < nt; t += 2) {
            const bool last = (t == nt - 2);
            const char* a1 = cA + (size_t)(t + 1) * kstep;
            const char* a2 = last ? nA : cA + (size_t)(t + 2) * kstep; const char* b2 = last ? nB : cB + (size_t)(t + 2) * kstep;
            const char* a3 = a2 + kstep; const char* b3 = b2 + kstep;
            if (last && has_next) S.a_ready(nxt);
            if constexpr (SP2) {
            PG8_LDB(B0, 0, 0); PG8_LDB(B1, 0, 1); PG8_SCHED; PG8_LDA(At, 0, 0); PG8_STAGE(PG8_SA(1, 1), a1 + hstep, voffA);
            PG8_WAIT_V(8); PG8_WAIT_L(0); PG8_BAR; PG8_MMA(0, 0, At, B0); PG8_MMA(0, 1, At, B1); PG8_BAR; PG8_SCHED;
            PG8_LDA(At, 0, 1); PG8_STAGE(PG8_SB(0, 0), b2, voffB); PG8_STAGE(PG8_SB(0, 1), b2 + hstep, voffB); PG8_STAGE(PG8_SA(0, 0), a2, voffA);
            PG8_WAIT_V(8); PG8_WAIT_L(0); PG8_BAR; PG8_MMA(1, 0, At, B0); PG8_MMA(1, 1, At, B1); PG8_BAR; PG8_SCHED;
            PG8_LDB(B0, 1, 0); PG8_LDB(B1, 1, 1); PG8_SCHED; PG8_LDA(At, 1, 0); PG8_STAGE(PG8_SA(0, 1), a2 + hstep, voffA);
            PG8_WAIT_V(8); PG8_WAIT_L(0); PG8_BAR; PG8_MMA(0, 0, At, B0); PG8_MMA(0, 1, At, B1); PG8_BAR; PG8_SCHED;
            PG8_LDA(At, 1, 1); PG8_STAGE(PG8_SB(1, 0), b3, voffB); PG8_STAGE(PG8_SB(1, 1), b3 + hstep, voffB); PG8_STAGE(PG8_SA(1, 0), a3, voffA);
            PG8_WAIT_V(8); PG8_WAIT_L(0); PG8_BAR; PG8_MMA(1, 0, At, B0); PG8_MMA(1, 1, At, B1); PG8_BAR; PG8_SCHED;
            } else {
            PG8_LDB(B0, 0, 0); PG8_SCHED; PG8_LDA(At, 0, 0); PG8_STAGE(PG8_SA(1, 1), a1 + hstep, voffA);
            PG8_WAIT_L(8); PG8_BAR; PG8_WAIT_L(0); PG8_MMA(0, 0, At, B0); PG8_BAR; PG8_SCHED;
            PG8_LDB(B1, 0, 1); PG8_STAGE(PG8_SB(0, 0), b2, voffB);
            PG8_BAR; PG8_WAIT_L(0); PG8_MMA(0, 1, At, B1); PG8_BAR;
            PG8_LDA(At, 0, 1); PG8_STAGE(PG8_SA(0, 0), a2, voffA);
            PG8_BAR; PG8_WAIT_L(0); PG8_MMA(1, 0, At, B0); PG8_BAR; PG8_SCHED;
            PG8_STAGE(PG8_SB(0, 1), b2 + hstep, voffB);
            PG8_WAIT_V(6); PG8_BAR; PG8_MMA(1, 1, At, B1); PG8_BAR;
            PG8_LDB(B0, 1, 0); PG8_SCHED; PG8_LDA(At, 1, 0); PG8_STAGE(PG8_SA(0, 1), a2 + hstep, voffA);
            PG8_WAIT_L(8); PG8_BAR; PG8_WAIT_L(0); PG8_MMA(0, 0, At, B0); PG8_BAR; PG8_SCHED;
            PG8_LDB(B1, 1, 1); PG8_STAGE(PG8_SB(1, 0), b3, voffB);
            PG8_BAR; PG8_WAIT_L(0); PG8_MMA(0, 1, At, B1); PG8_BAR;
            PG8_LDA(At, 1, 1); PG8_STAGE(PG8_SA(1, 0), a3, voffA);
            PG8_BAR; PG8_WAIT_L(0); PG8_MMA(1, 0, At, B0); PG8_BAR; PG8_SCHED;
            PG8_STAGE(PG8_SB(1, 1), b3 + hstep, voffB);
            PG8_WAIT_V(6); PG8_BAR; PG8_MMA(1, 1, At, B1); PG8_BAR;
            }
        }
        if constexpr (ALIGN_EPI) { if (wr == 0) PG8_BAR; }
        if constexpr (!Epi::AFTER_DRAIN) { E(acc, cur, wr, wc, fr, fq); S.done(cur); }
        if (!has_next) break;
#pragma unroll
        for (int a = 0; a < 2; ++a)
#pragma unroll
            for (int b = 0; b < 2; ++b)
#pragma unroll
                for (int m = 0; m < 4; ++m)
#pragma unroll
                    for (int n = 0; n < 2; ++n) acc[a][b][m][n] = (f32x4){0.f, 0.f, 0.f, 0.f};
        cur = nxt; cA = nA; cB = nB; ++ui;
        if constexpr (ALIGN_EPI) { if (wr == 1) PG8_BAR; }
    }
    PG8_WAIT_V(0);
    if constexpr (!ALIGN_EPI) { if (wr == 0) PG8_BAR; }
    PG8_BAR;
    if constexpr (Epi::AFTER_DRAIN) { E.fused(acc, cur, wr, wc, fr, fq, lds, wid, lane); S.done(cur); }
#undef PG8_SA
#undef PG8_SB
#undef PG8_STAGE
#undef PG8_LDA
#undef PG8_LDB
#undef PG8_MMA
#undef PG8_WAIT_V
#undef PG8_WAIT_L
#undef PG8_BAR
#undef PG8_SCHED
}
}

#ifndef PG8_SP2
#define PG8_SP2 true
#endif
#ifndef PG8_ALIGN
#define PG8_ALIGN true
#endif

namespace mk {
using pg8::f32x4; using pg8::bf16x8; using pg8::u32x4; using pg8::Unit; using pg8::Gemm; using pg8::bf16_t; using pg8::cvt_pk_bf16; using pg8::perm32;
typedef unsigned u32x2 __attribute__((ext_vector_type(2)));
constexpr int BM = 256, HALF = 128;

__device__ __forceinline__ float row_rstd(const float* RS, int row) {
    float ss;
    if (row < MP) { const f32x4 p = *(const f32x4*)(RS + (size_t)row * 4); ss = (p[0] + p[1]) + (p[2] + p[3]); }
    else { const f32x4* q = (const f32x4*)(RS + (size_t)MP * 4 + (size_t)(row - MP) * 16); const f32x4 a = q[0], b = q[1], c = q[2], d = q[3];
           ss = (((a[0] + a[1]) + (a[2] + a[3])) + ((b[0] + b[1]) + (b[2] + b[3]))) + (((c[0] + c[1]) + (c[2] + c[3])) + ((d[0] + d[1]) + (d[2] + d[3]))); }
    return rsqrtf(ss * (1.0f / D) + NORM_EPS);
}
__device__ __forceinline__ void unit_rstd(const float* RS, int row0, float (&rs)[2][4]) {
    if (row0 < MP) {
        f32x4 p[2][4];
#pragma unroll
        for (int ai = 0; ai < 2; ++ai)
#pragma unroll
            for (int m = 0; m < 4; ++m) p[ai][m] = *(const f32x4*)(RS + (size_t)(row0 + ai * HALF + m * 16) * 4);
#pragma unroll
        for (int ai = 0; ai < 2; ++ai)
#pragma unroll
            for (int m = 0; m < 4; ++m) rs[ai][m] = rsqrtf(((p[ai][m][0] + p[ai][m][1]) + (p[ai][m][2] + p[ai][m][3])) * (1.0f / D) + NORM_EPS);
    } else {
#pragma unroll
        for (int ai = 0; ai < 2; ++ai)
#pragma unroll
            for (int m = 0; m < 4; ++m) rs[ai][m] = row_rstd(RS, row0 + ai * HALF + m * 16);
    }
}
__device__ __forceinline__ float silu_mul(float g, float u) {
    const float e = __builtin_amdgcn_exp2f(-g * LOG2E);
    return g * u * __builtin_amdgcn_rcpf(1.0f + e);
}
__device__ __forceinline__ float log_sigmoid(float x) { return fminf(x, 0.f) - log1pf(__expf(-fabsf(x))); }

struct RoundOrder : pg8::StaticOrder {
    int rnd;
    __device__ __forceinline__ bool next(int i, Unit& u) const { if (i > 0) return false; return pg8::StaticOrder::next(rnd, u); }
};

struct EpiSwiglu {
    static constexpr bool PERM = true, AFTER_DRAIN = false;
    bf16_t* Hout; const float* RS;
    __device__ __forceinline__ void operator()(const f32x4 (&acc)[2][2][4][2], const Unit& u, int wr, int wc, int fr, int fq) const {
        const int row0 = u.pm * BM + wr * 64 + fr, col0 = u.pn * HALF + wc * 32 + 8 * fq;
        float rs[2][4]; unit_rstd(RS, row0, rs);
#pragma unroll
        for (int ai = 0; ai < 2; ++ai)
#pragma unroll
            for (int m = 0; m < 4; ++m) {
                const int row = row0 + ai * HALF + m * 16; const float r = rs[ai][m];
                const f32x4 g0 = acc[ai][0][m][0] * r, g1 = acc[ai][0][m][1] * r, u0 = acc[ai][1][m][0] * r, u1 = acc[ai][1][m][1] * r;
                u32x4 w;
                w.x = cvt_pk_bf16(silu_mul(g0[0], u0[0]), silu_mul(g0[1], u0[1])); w.y = cvt_pk_bf16(silu_mul(g0[2], u0[2]), silu_mul(g0[3], u0[3]));
                w.z = cvt_pk_bf16(silu_mul(g1[0], u1[0]), silu_mul(g1[1], u1[1])); w.w = cvt_pk_bf16(silu_mul(g1[2], u1[2]), silu_mul(g1[3], u1[3]));
                *(u32x4*)(Hout + (size_t)row * FF + col0) = w;
            }
    }
};

template <bool BASE_F32  , bool OUT_F32  > struct EpiRes {
    static constexpr bool PERM = false, AFTER_DRAIN = true;
    const float* base_p; const float* base_s; float* X; bf16_t* XB; float* RS; float scale;
    __device__ __forceinline__ void fused(f32x4 (&acc)[2][2][4][2], const Unit& u, int wr, int wc, int fr, int fq, PG8_LAS unsigned char* lds, int wid, int lane) const {
        PG8_LAS float* P = (PG8_LAS float*)lds;
        const int col0 = u.pn * BM + wc * 32 + 4 * fq;
#pragma unroll
        for (int ai = 0; ai < 2; ++ai)
#pragma unroll
            for (int m = 0; m < 4; ++m) {
                const int rl = ai * HALF + wr * 64 + m * 16 + fr, row = u.pm * BM + rl;
                const float* bp = row < MP ? base_p + (size_t)row * D : base_s + (size_t)(row - MP) * D;
                float ss = 0.f;
#pragma unroll
                for (int bj = 0; bj < 2; ++bj)
#pragma unroll
                    for (int n = 0; n < 2; ++n) {
                        const int c = col0 + bj * HALF + n * 16;
                        f32x4 b;
                        if (BASE_F32) b = *(const f32x4*)(bp + c);
                        else { const u32x2 wb = *(const u32x2*)(XB + (size_t)row * D + c); b = (f32x4){__builtin_bit_cast(float, wb.x << 16), __builtin_bit_cast(float, wb.x & 0xffff0000u), __builtin_bit_cast(float, wb.y << 16), __builtin_bit_cast(float, wb.y & 0xffff0000u)}; }
                        const f32x4 v = b + acc[ai][bj][m][n] * scale;
                        if (OUT_F32) *(f32x4*)(X + (size_t)row * D + c) = v;
                        else { u32x2 w; w.x = cvt_pk_bf16(v[0], v[1]); w.y = cvt_pk_bf16(v[2], v[3]); *(u32x2*)(XB + (size_t)row * D + c) = w; }
                        ss += (v[0] * v[0] + v[1] * v[1]) + (v[2] * v[2] + v[3] * v[3]);
                    }
                ss += __shfl_xor(ss, 16); ss += __shfl_xor(ss, 32);
                if (fq == 0) P[rl * 4 + wc] = ss;
                if (m & 1) asm volatile("" ::: "memory");
            }
        asm volatile("s_waitcnt lgkmcnt(0)" ::: "memory"); __builtin_amdgcn_s_barrier(); asm volatile("" ::: "memory");
        const int t = wid * 64 + lane;
        if (!OUT_F32 && t < 256) { const f32x4 p = *(const PG8_LAS f32x4*)(P + t * 4); RS[(size_t)(u.pm * BM + t) * 4 + u.pn] = (p[0] + p[1]) + (p[2] + p[3]); }
        asm volatile("s_waitcnt lgkmcnt(0)" ::: "memory"); __builtin_amdgcn_s_barrier(); asm volatile("" ::: "memory");
    }
};

struct EpiConvIn {
    static constexpr bool PERM = true, AFTER_DRAIN = false;
    bf16_t* G; bf16_t* U; const float* RS; float* cs_p; float* cs_s;
    __device__ __forceinline__ void operator()(const f32x4 (&acc)[2][2][4][2], const Unit& u, int wr, int wc, int fr, int fq) const {
        const int row0 = u.pm * BM + wr * 64 + fr;
        float rs[2][4]; unit_rstd(RS, row0, rs);
        if (u.pn < 4) {
            const int col0 = u.pn * BM + wc * 32 + 8 * fq;
#pragma unroll
            for (int ai = 0; ai < 2; ++ai)
#pragma unroll
                for (int m = 0; m < 4; ++m) {
                    const int row = row0 + ai * HALF + m * 16; const float r = rs[ai][m];
#pragma unroll
                    for (int bj = 0; bj < 2; ++bj) { const f32x4 v0 = acc[ai][bj][m][0] * r, v1 = acc[ai][bj][m][1] * r;
                        u32x4 w; w.x = cvt_pk_bf16(v0[0], v0[1]); w.y = cvt_pk_bf16(v0[2], v0[3]); w.z = cvt_pk_bf16(v1[0], v1[1]); w.w = cvt_pk_bf16(v1[2], v1[3]);
                        *(u32x4*)(G + (size_t)row * D + col0 + bj * HALF) = w; }
                }
        } else {
            const int col0 = (u.pn - 4) * HALF + wc * 32 + 8 * fq;
#pragma unroll
            for (int ai = 0; ai < 2; ++ai)
#pragma unroll
                for (int m = 0; m < 4; ++m) {
                    const int row = row0 + ai * HALF + m * 16; const float r = rs[ai][m], r2 = r * r;
                    const f32x4 v0 = acc[ai][0][m][0] * acc[ai][1][m][0] * r2, v1 = acc[ai][0][m][1] * acc[ai][1][m][1] * r2;
                    u32x4 w; w.x = cvt_pk_bf16(v0[0], v0[1]); w.y = cvt_pk_bf16(v0[2], v0[3]); w.z = cvt_pk_bf16(v1[0], v1[1]); w.w = cvt_pk_bf16(v1[2], v1[3]);
                    *(u32x4*)(U + (size_t)row * D + col0) = w;
                    float* cs = nullptr;
                    if (row < MP) { const int t = row & (SEQ - 1); if (t >= SEQ - 2) cs = cs_p + ((size_t)(row >> 11) * 2 + (t - (SEQ - 2))) * D; }
                    else { const int rr = row - MP, t = rr & (DSEQ - 1); if (t >= DSEQ - 2) cs = cs_s + ((size_t)(rr >> 6) * 2 + (t - (DSEQ - 2))) * D; }
                    if (cs) { *(f32x4*)(cs + col0) = v0; *(f32x4*)(cs + col0 + 4) = v1; }
                }
        }
    }
};

struct EpiAttnIn {
    static constexpr bool PERM = true, AFTER_DRAIN = false;
    bf16_t *Qb, *Kb, *Vb; const float* RS; const float *gq, *gk, *bfg; float *k_p, *k_s, *v_p, *v_s, *lf_p, *lf_s;
    __device__ __forceinline__ void operator()(const f32x4 (&acc)[2][2][4][2], const Unit& u, int wr, int wc, int fr, int fq) const {
        const int row0 = u.pm * BM + wr * 64 + fr, pn = u.pn;
        float rs[2][4]; unit_rstd(RS, row0, rs);
        if (pn < 8) {
            const bool isq = pn < 4; const float* gg = isq ? gq : gk;
            f32x4 gv[2][2];
#pragma unroll
            for (int bj = 0; bj < 2; ++bj)
#pragma unroll
                for (int n = 0; n < 2; ++n) gv[bj][n] = *(const f32x4*)(gg + 32 * bj + 8 * fq + 4 * n);
            const int hcol = ((pn & 3) * 4 + wc) * HD + 8 * fq;
#pragma unroll
            for (int ai = 0; ai < 2; ++ai)
#pragma unroll
                for (int m = 0; m < 4; ++m) {
                    const int row = row0 + ai * HALF + m * 16; const float r = rs[ai][m];
                    float ss = 0.f;
#pragma unroll
                    for (int bj = 0; bj < 2; ++bj)
#pragma unroll
                        for (int n = 0; n < 2; ++n) { const f32x4 a = acc[ai][bj][m][n]; ss += (a[0] * a[0] + a[1] * a[1]) + (a[2] * a[2] + a[3] * a[3]); }
                    ss += __shfl_xor(ss, 16); ss += __shfl_xor(ss, 32);
                    const float f = r * rsqrtf(r * r * ss * (1.0f / HD) + NORM_EPS);
                    float* ko = nullptr; if (!isq) ko = (row < MP ? k_p + (size_t)row * D : k_s + (size_t)(row - MP) * D) + hcol;
#pragma unroll
                    for (int bj = 0; bj < 2; ++bj) {
                        const f32x4 o0 = acc[ai][bj][m][0] * f * gv[bj][0], o1 = acc[ai][bj][m][1] * f * gv[bj][1];
                        if (isq) { const f32x4 s0 = o0 * QSCALE, s1 = o1 * QSCALE;
                            u32x4 w; w.x = cvt_pk_bf16(s0[0], s0[1]); w.y = cvt_pk_bf16(s0[2], s0[3]); w.z = cvt_pk_bf16(s1[0], s1[1]); w.w = cvt_pk_bf16(s1[2], s1[3]);
                            *(u32x4*)(Qb + (size_t)row * D + hcol + 32 * bj) = w; }
                        else { u32x4 w; w.x = cvt_pk_bf16(o0[0], o0[1]); w.y = cvt_pk_bf16(o0[2], o0[3]); w.z = cvt_pk_bf16(o1[0], o1[1]); w.w = cvt_pk_bf16(o1[2], o1[3]);
                            *(u32x4*)(Kb + (size_t)row * D + hcol + 32 * bj) = w;
                            *(f32x4*)(ko + 32 * bj) = o0; *(f32x4*)(ko + 32 * bj + 4) = o1; }
                    }
                }
        } else if (pn < 12) {
            const int col0 = (pn - 8) * BM + wc * 32 + 8 * fq;
#pragma unroll
            for (int ai = 0; ai < 2; ++ai)
#pragma unroll
                for (int m = 0; m < 4; ++m) {
                    const int row = row0 + ai * HALF + m * 16; const float r = rs[ai][m];
                    float* vo = (row < MP ? v_p + (size_t)row * D : v_s + (size_t)(row - MP) * D) + col0;
#pragma unroll
                    for (int bj = 0; bj < 2; ++bj) { const f32x4 o0 = acc[ai][bj][m][0] * r, o1 = acc[ai][bj][m][1] * r;
                        u32x4 w; w.x = cvt_pk_bf16(o0[0], o0[1]); w.y = cvt_pk_bf16(o0[2], o0[3]); w.z = cvt_pk_bf16(o1[0], o1[1]); w.w = cvt_pk_bf16(o1[2], o1[3]);
                        *(u32x4*)(Vb + (size_t)row * D + col0 + bj * HALF) = w;
                        *(f32x4*)(vo + bj * HALF) = o0; *(f32x4*)(vo + bj * HALF + 4) = o1; }
                }
        } else {
            if (wc == 0 && fq < 2) {
                const f32x4 b0 = *(const f32x4*)(bfg + 8 * fq), b1 = *(const f32x4*)(bfg + 8 * fq + 4);
#pragma unroll
                for (int ai = 0; ai < 2; ++ai)
#pragma unroll
                    for (int m = 0; m < 4; ++m) {
                        const int row = row0 + ai * HALF + m * 16; const float r = rs[ai][m];
                        float* lo = (row < MP ? lf_p + (size_t)row * NH : lf_s + (size_t)(row - MP) * NH) + 8 * fq;
                        const f32x4 a0 = acc[ai][0][m][0] * r + b0, a1 = acc[ai][0][m][1] * r + b1;
                        f32x4 l0, l1;
#pragma unroll
                        for (int j = 0; j < 4; ++j) { l0[j] = log_sigmoid(a0[j]); l1[j] = log_sigmoid(a1[j]); }
                        *(f32x4*)lo = l0; *(f32x4*)(lo + 4) = l1;
                    }
            }
        }
    }
};

template <class Epi, class Sched>
__device__ __forceinline__ void gemm_phase_simple(PG8_LAS unsigned char* lds, const Gemm g, const Sched& S, const Epi& E) {
    int tid = threadIdx.x; asm volatile("" : "+v"(tid));
    const int wid = __builtin_amdgcn_readfirstlane(tid >> 6), lane = tid & 63, wr = wid >> 2, wc = wid & 3, fr = lane & 15, fq = lane >> 4;
    const int K = g.K;
    Unit cur;
    for (int ui = 0; S.next(ui, cur); ++ui) {
        f32x4 acc[2][2][4][2];
#pragma unroll
        for (int a = 0; a < 2; ++a)
#pragma unroll
            for (int b = 0; b < 2; ++b)
#pragma unroll
                for (int m = 0; m < 4; ++m)
#pragma unroll
                    for (int n = 0; n < 2; ++n) acc[a][b][m][n] = (f32x4){0.f, 0.f, 0.f, 0.f};
        const bf16_t* Ab = g.A + (size_t)(cur.pm * BM + wr * 64 + fr) * K + fq * 8;
        const bf16_t* Bb = g.Bt + (size_t)(cur.pn * BM + wc * 32) * K + fq * 8;
        const int br0 = Epi::PERM ? perm32(fr) : fr, br1 = Epi::PERM ? perm32(16 + fr) : 16 + fr;
        for (int kt = 0; kt < K; kt += 32) {
            bf16x8 a[2][4], b[2][2];
#pragma unroll
            for (int ai = 0; ai < 2; ++ai)
#pragma unroll
                for (int m = 0; m < 4; ++m) a[ai][m] = *(const bf16x8*)(Ab + (size_t)(ai * HALF + m * 16) * K + kt);
#pragma unroll
            for (int bj = 0; bj < 2; ++bj) { b[bj][0] = *(const bf16x8*)(Bb + (size_t)(bj * HALF + br0) * K + kt); b[bj][1] = *(const bf16x8*)(Bb + (size_t)(bj * HALF + br1) * K + kt); }
#pragma unroll
            for (int ai = 0; ai < 2; ++ai)
#pragma unroll
                for (int bj = 0; bj < 2; ++bj)
#pragma unroll
                    for (int m = 0; m < 4; ++m)
#pragma unroll
                        for (int n = 0; n < 2; ++n) acc[ai][bj][m][n] = __builtin_amdgcn_mfma_f32_16x16x32_bf16(b[bj][n], a[ai][m], acc[ai][bj][m][n], 0, 0, 0);
        }
        if constexpr (Epi::AFTER_DRAIN) { __syncthreads(); E.fused(acc, cur, wr, wc, fr, fq, lds, wid, lane); __syncthreads(); }
        else E(acc, cur, wr, wc, fr, fq);
    }
}
}
#include <hip/hip_bf16.h>
#include <cmath>
namespace attn_body {
using bf16=__hip_bfloat16;
using bf16x8=__attribute__((ext_vector_type(8)))short;
using s16x4=__attribute__((ext_vector_type(4)))short;
using f32x16=__attribute__((ext_vector_type(16)))float;
using u32x4=__attribute__((ext_vector_type(4)))unsigned;
constexpr int BATCH=8,NHEAD=16,SEQ=2048,D=64,DM=NHEAD*D;
constexpr int NW=8,QBLK=32,QB=QBLK*NW,KVBLK=64,NQB=SEQ/QB;
constexpr int ATTN_PITCH=DM, ATTN_UNIT_ROWS=QB;
__device__ __forceinline__ int crow(int r,int hi){return (r&3)+8*(r>>2)+4*hi;}
#define SBAR() __builtin_amdgcn_sched_barrier(0)
__device__ __forceinline__ void cmask(f32x16&p0,f32x16&p1,int jb,int qrel,int hi){
  const float NEG=-INFINITY; int kb=64*jb+4*hi;
  #pragma unroll
  for(int r=0;r<16;++r){int kv=kb+(r&3)+8*(r>>2); if(kv>qrel)p0[r]=NEG; if(kv+32>qrel)p1[r]=NEG;}
}

constexpr int NSLOT=3, SLOTB=8192;
constexpr int LDS_K=0, LDS_V=NSLOT*SLOTB, LDS_WS=2*NSLOT*SLOTB, LDS_OST=LDS_WS+NW*64*4, LDS_BYTES=LDS_OST+NW*4096;
constexpr float C2=0.125f*1.4426950408889634f;
__device__ __forceinline__ void glds16(const void*gsrc,unsigned lds_dst){unsigned keep;
  asm volatile("s_mov_b32 %0, m0\n\ts_mov_b32 m0, %2\n\ts_nop 0\n\tglobal_load_lds_dwordx4 %1, off\n\ts_mov_b32 m0, %0":"=&s"(keep):"v"(gsrc),"s"(lds_dst):"memory");}
__device__ __forceinline__ float max3f(float a,float b,float c){float r;asm("v_max3_f32 %0, %1, %2, %3":"=v"(r):"v"(a),"v"(b),"v"(c));return r;}
__device__ __forceinline__ float max2f(float a,float b){float r;asm("v_max_f32_e32 %0, %1, %2":"=v"(r):"v"(a),"v"(b));return r;}
__device__ __forceinline__ float fadd_s(float a,float b){float r;asm("v_add_f32_e32 %0, %1, %2":"=v"(r):"v"(a),"v"(b));return r;}
__device__ __forceinline__ float fsub_s(float a,float b){float r;asm("v_sub_f32_e32 %0, %1, %2":"=v"(r):"v"(a),"v"(b));return r;}
typedef float f32x2_t __attribute__((ext_vector_type(2))); typedef __bf16 bf16x2_t __attribute__((ext_vector_type(2)));
__device__ __forceinline__ unsigned cvtpk_s(float lo,float hi){f32x2_t v={lo,hi};bf16x2_t b=__builtin_convertvector(v,bf16x2_t);return __builtin_bit_cast(unsigned,b);}
#define WAIT_BAR(N) asm volatile("s_waitcnt vmcnt(" #N ") lgkmcnt(0)\n\ts_barrier":::"memory")

__device__ __forceinline__ void qkt(f32x16&p0,f32x16&p1,const char*Kslot,const bf16x8*qr,int r32,int hi){
  const char*kb=Kslot+hi*1024+r32*16;
  #pragma unroll
  for(int d0=0;d0<4;++d0){
    const bf16x8 b0=*reinterpret_cast<const bf16x8*>(kb+d0*2048);
    const bf16x8 b1=*reinterpret_cast<const bf16x8*>(kb+d0*2048+512);
    if(d0==0){p0=__builtin_amdgcn_mfma_f32_32x32x16_bf16(b0,qr[0],f32x16{},0,0,0);p1=__builtin_amdgcn_mfma_f32_32x32x16_bf16(b1,qr[0],f32x16{},0,0,0);}
    else{p0=__builtin_amdgcn_mfma_f32_32x32x16_bf16(b0,qr[d0],p0,0,0,0);p1=__builtin_amdgcn_mfma_f32_32x32x16_bf16(b1,qr[d0],p1,0,0,0);}}
}
typedef __attribute__((address_space(3))) const char* lds_cptr;
typedef short v4i16_t __attribute__((ext_vector_type(4)));
__device__ __forceinline__ void kload8(bf16x8*kf,lds_cptr kp){
  kf[0]=*(const __attribute__((address_space(3))) bf16x8*)(kp);      kf[1]=*(const __attribute__((address_space(3))) bf16x8*)(kp+512);
  kf[2]=*(const __attribute__((address_space(3))) bf16x8*)(kp+2048); kf[3]=*(const __attribute__((address_space(3))) bf16x8*)(kp+2560);
  kf[4]=*(const __attribute__((address_space(3))) bf16x8*)(kp+4096); kf[5]=*(const __attribute__((address_space(3))) bf16x8*)(kp+4608);
  kf[6]=*(const __attribute__((address_space(3))) bf16x8*)(kp+6144); kf[7]=*(const __attribute__((address_space(3))) bf16x8*)(kp+6656);
}
__device__ __forceinline__ void kload2(bf16x8*kf,lds_cptr kp,int j){ kf[2*j]=*(const __attribute__((address_space(3))) bf16x8*)(kp+j*2048); kf[2*j+1]=*(const __attribute__((address_space(3))) bf16x8*)(kp+j*2048+512); }
__device__ __forceinline__ s16x4 vtr(lds_cptr p){ return __builtin_bit_cast(s16x4,__builtin_amdgcn_ds_read_tr16_b64_v4i16((__attribute__((address_space(3))) v4i16_t*)p)); }
__device__ __forceinline__ float rowmax(const f32x16&p0,const f32x16&p1){
  float a=max3f(p0[0],p0[1],p1[0]),b=max3f(p0[2],p0[3],p1[1]);a=max3f(a,p1[2],p1[3]);
  #pragma unroll
  for(int r=4;r<16;r+=4){a=max3f(a,p0[r],p0[r+1]);b=max3f(b,p0[r+2],p0[r+3]);a=max3f(a,p1[r],p1[r+1]);b=max3f(b,p1[r+2],p1[r+3]);}
  const float m=max2f(a,b);
  auto rr=__builtin_amdgcn_permlane32_swap(__float_as_uint(m),__float_as_uint(m),false,false);
  return max2f(__uint_as_float(rr[0]),__uint_as_float(rr[1]));
}
__device__ __forceinline__ void pv(f32x16*o,int vb,bf16x8 pa0,bf16x8 pa1,bf16x8 pa2,bf16x8 pa3){
  #pragma unroll
  for(int d0=0;d0<2;++d0){s16x4 lo[4],hi[4];
    #pragma unroll
    for(int ks=0;ks<4;++ks){
      asm volatile("ds_read_b64_tr_b16 %0,%1 offset:%c2":"=&v"(lo[ks]):"v"(vb),"i"(d0*4096+ks*1024):"memory");
      asm volatile("ds_read_b64_tr_b16 %0,%1 offset:%c2":"=&v"(hi[ks]):"v"(vb),"i"(d0*4096+ks*1024+512):"memory");}
    asm volatile("s_waitcnt lgkmcnt(0)":::"memory");SBAR();
    #define PK(k) (bf16x8){lo[k][0],lo[k][1],lo[k][2],lo[k][3],hi[k][0],hi[k][1],hi[k][2],hi[k][3]}
    o[d0]=__builtin_amdgcn_mfma_f32_32x32x16_bf16(pa0,PK(0),o[d0],0,0,0);
    o[d0]=__builtin_amdgcn_mfma_f32_32x32x16_bf16(pa1,PK(1),o[d0],0,0,0);
    o[d0]=__builtin_amdgcn_mfma_f32_32x32x16_bf16(pa2,PK(2),o[d0],0,0,0);
    o[d0]=__builtin_amdgcn_mfma_f32_32x32x16_bf16(pa3,PK(3),o[d0],0,0,0);
    #undef PK
  }
}

#ifndef ATTN_STORE16
#define ATTN_STORE16(p,v) (*(u32x4*)(p)=(v))
#endif
template<int THRL> __device__ __forceinline__ void attn_unit(int b,int h,int qb,const bf16*Q,const bf16*__restrict__ K,const bf16*__restrict__ V,bf16*O,char*shm,lds_cptr btab,lds_cptr zblk){
  int tid=threadIdx.x; asm volatile("":"+v"(tid)); const int lane=tid&63,r32=lane&31,hi=lane>>5; const int wid=__builtin_amdgcn_readfirstlane(tid>>6);
  const long rowbase=(long)b*SEQ; const int q0=qb*QB;
  const bf16*Qw=Q+(rowbase+q0+wid*QBLK)*DM+h*D;
  const bf16*Kh=K+rowbase*DM+h*D,*Vh=V+rowbase*DM+h*D;
  const unsigned lds0=(unsigned)(uintptr_t)shm;
  float*wsf=(float*)(shm+LDS_WS)+wid*64;
  const bf16*ksrc=Kh+(long)lane*DM+wid*8;
  const bf16*vsrc=Vh+(long)(16*(wid&3)+(lane>>2))*DM+(wid>>2)*32+(lane&3)*8;
  const unsigned kdst=lds0+LDS_K+wid*1024, vdst=lds0+LDS_V+wid*1024;
  #define DMA_K(t,slot) glds16(ksrc+(long)(t)*KVBLK*DM,(unsigned)__builtin_amdgcn_readfirstlane(kdst+(slot)))
  #define DMA_V(t,slot) glds16(vsrc+(long)(t)*KVBLK*DM,(unsigned)__builtin_amdgcn_readfirstlane(vdst+(slot)))
  const int vb0=(int)(lds0+LDS_V)+((lane>>4)&1)*32+(lane&3)*8+(4*hi+((lane&15)>>2))*64;
  const char*Kbase=shm+LDS_K; bf16x8 kf[8];
  const lds_cptr shm3=(lds_cptr)shm; const lds_cptr kp0=shm3+LDS_K+hi*1024+r32*16; const lds_cptr vp0=shm3+LDS_V+((lane>>4)&1)*32+(lane&3)*8+(4*hi+((lane&15)>>2))*64;
  const int NT=(q0+QB)/KVBLK;
  DMA_K(0,0);DMA_V(0,0);DMA_K(1,SLOTB);
  bf16x8 qr[4];
  #pragma unroll
  for(int d0=0;d0<4;++d0)qr[d0]=*reinterpret_cast<const bf16x8*>(&Qw[(long)r32*DM+d0*16+hi*8]);
  float mhat=0.f,l_reg=0.f;f32x16 o[2];o[0]=f32x16{};o[1]=f32x16{};unsigned qx1=0x00003F80u,qx2=0u;
  const int qrel=wid*QBLK+r32;
  const lds_cptr bx0=btab+r32*16;
  #define KXLD(t_,kxa,kxb) do{ const lds_cptr p_=bx0+(t_)*1024; kxa=*(const __attribute__((address_space(3))) bf16x8*)(p_); kxb=*(const __attribute__((address_space(3))) bf16x8*)(p_+512); }while(0)
  #define QX() __builtin_bit_cast(bf16x8,(u32x4){0x3F803F80u,qx1,qx2,0u})
  #define SETM() do{ const float mm_=-0.5f*mhat; qx1=cvtpk_s(1.0f,mm_); const float r1_=mm_-__uint_as_float(qx1&0xffff0000u); const unsigned t2_=cvtpk_s(r1_,r1_); const float r2_=r1_-__uint_as_float(t2_<<16); qx2=cvtpk_s(r1_,r2_); }while(0)
  #define CMASK(P0,P1,t) do{int jb_=(t)-(NT-4); if(jb_>=0)cmask(P0,P1,jb_,qrel,hi);}while(0)
  bool resc=false;
  #define START(P0,P1) do{ const float rm=rowmax(P0,P1); resc=false; \
    { const float dl=rm; mhat=fadd_s(mhat,dl); \
      _Pragma("unroll") for(int r=0;r<16;++r){P0[r]=fsub_s(P0[r],dl);P1[r]=fsub_s(P1[r],dl);} \
      SETM(); } \
    _Pragma("unroll") for(int r=0;r<16;++r)P0[r]=__builtin_amdgcn_exp2f(P0[r]); }while(0)
  #define RESC() do{ if(resc){ asm volatile("s_waitcnt lgkmcnt(0)":::"memory"); \
      _Pragma("unroll") for(int d_=0;d_<2;++d_) _Pragma("unroll") for(int r=0;r<16;++r)o[d_][r]*=wsf[crow(r,hi)]; } }while(0)
  f32x16 pA0,pA1,pB0,pB1;
  int sl_prev=0,sl_cur=0,sl_next=SLOTB;
  #define ROT() do{sl_prev=sl_cur;sl_cur=sl_next;sl_next=(sl_next==(NSLOT-1)*SLOTB)?0:sl_next+SLOTB;}while(0)
  DMA_K(2,2*SLOTB);
  WAIT_BAR(3);
  qkt(pA0,pA1,Kbase,qr,r32,hi);
  { bf16x8 kxa,kxb; KXLD(0,kxa,kxb); pA0=__builtin_amdgcn_mfma_f32_32x32x16_bf16(kxa,QX(),pA0,0,0,0); pA1=__builtin_amdgcn_mfma_f32_32x32x16_bf16(kxb,QX(),pA1,0,0,0); }
  asm volatile("s_nop 15\n\ts_nop 7":"+v"(pA0),"+v"(pA1));CMASK(pA0,pA1,0);
  START(pA0,pA1);
  _Pragma("unroll") for(int r=0;r<16;++r)pA1[r]=__builtin_amdgcn_exp2f(pA1[r]);
  WAIT_BAR(0);
  DMA_K(3,0);DMA_V(1,SLOTB);
  ROT();
  kload8(kf,kp0+sl_cur);
  WAIT_BAR(2);
  s16x4 vlo[8],vhi[8]; u32x4 pw0,pw1,pw2,pw3;
  #define PKW(P,B) cvtpk_s(P[B],P[B+1])
  #define PAF(k) __builtin_bit_cast(bf16x8,pw##k)
  #define VFR(i) (bf16x8){vlo[i][0],vlo[i][1],vlo[i][2],vlo[i][3],vhi[i][0],vhi[i][1],vhi[i][2],vhi[i][3]}
  #define PIN(x) asm volatile("":"+v"(x))
  #define MX3(a,b,c) __builtin_fmaxf(__builtin_fmaxf((a),(b)),(c))
  #define GAPA(MF,A0,A1,A2,A3,W0,W1,PW) do{ MF; sacc+=A0; sacc+=A1; sacc+=A2; sacc+=A3; PIN(sacc); W0; W1; PIN(PW); SBAR(); }while(0)
  #define EX(v) __builtin_amdgcn_exp2f(v)
  #define GAPB(MF,X,B) do{ MF; X[B]=EX(X[B]); X[B+1]=EX(X[B+1]); X[B+2]=EX(X[B+2]); X[B+3]=EX(X[B+3]); PIN(X); SBAR(); }while(0)
  #define VRD(i) do{ vlo[i]=vtr(vp_+(((i)>>2)*4096+((i)&3)*1024)); vhi[i]=vtr(vp_+(((i)>>2)*4096+((i)&3)*1024+512)); }while(0)
  #define KRD(G,j) do{ if(G){ kload2(kf,kp0+sl_next,j); SBAR(); } }while(0)
  #define STEP(C0,C1,P0,P1,t,GK,GV,GL) do{ SBAR(); \
    const lds_cptr vp_=vp0+sl_prev; \
    bf16x8 kxa_,kxb_; \
    VRD(0); SBAR(); float sacc=(P0[0]+P0[1]); \
    GAPA(C0=__builtin_amdgcn_mfma_f32_32x32x16_bf16(kf[0],qr[0],f32x16{},0,0,0), P0[2],P0[3],P0[4],P0[5],     pw0[0]=PKW(P0,0), pw0[1]=PKW(P0,2), pw0); \
    VRD(4); SBAR(); GAPA(C1=__builtin_amdgcn_mfma_f32_32x32x16_bf16(kf[1],qr[0],f32x16{},0,0,0), P0[6],P0[7],P0[8],P0[9],     pw0[2]=PKW(P0,4), pw0[3]=PKW(P0,6), pw0); \
    VRD(1); SBAR(); GAPA(C0=__builtin_amdgcn_mfma_f32_32x32x16_bf16(kf[2],qr[1],C0,0,0,0),   P0[10],P0[11],P0[12],P0[13], pw1[0]=PKW(P0,8), pw1[1]=PKW(P0,10), pw1); \
    VRD(5); SBAR(); GAPA(C1=__builtin_amdgcn_mfma_f32_32x32x16_bf16(kf[3],qr[1],C1,0,0,0),   P0[14],P0[15],P1[0],P1[1],   pw1[2]=PKW(P0,12),pw1[3]=PKW(P0,14), pw1); \
    KXLD(t,kxa_,kxb_); VRD(2); SBAR(); GAPA(C0=__builtin_amdgcn_mfma_f32_32x32x16_bf16(kf[4],qr[2],C0,0,0,0),   P1[2],P1[3],P1[4],P1[5],     pw2[0]=PKW(P1,0), pw2[1]=PKW(P1,2), pw2); \
    VRD(6); SBAR(); GAPA(C1=__builtin_amdgcn_mfma_f32_32x32x16_bf16(kf[5],qr[2],C1,0,0,0),   P1[6],P1[7],P1[8],P1[9],     pw2[2]=PKW(P1,4), pw2[3]=PKW(P1,6), pw2); \
    VRD(3); SBAR(); GAPA(C0=__builtin_amdgcn_mfma_f32_32x32x16_bf16(kf[6],qr[3],C0,0,0,0),   P1[10],P1[11],P1[12],P1[13], pw3[0]=PKW(P1,8), pw3[1]=PKW(P1,10), pw3); \
    VRD(7); SBAR(); GAPA(C1=__builtin_amdgcn_mfma_f32_32x32x16_bf16(kf[7],qr[3],C1,0,0,0),   P1[14],P1[15],0.f,0.f,       pw3[2]=PKW(P1,12),pw3[3]=PKW(P1,14), pw3); \
    C0=__builtin_amdgcn_mfma_f32_32x32x16_bf16(kxa_,QX(),C0,0,0,0); C1=__builtin_amdgcn_mfma_f32_32x32x16_bf16(kxb_,QX(),C1,0,0,0); SBAR(); \
    l_reg+=sacc; \
    if(GK){DMA_K((t)+3,sl_cur);} if(GV){DMA_V((t)+1,sl_next);} \
    CMASK(C0,C1,t); \
    { float a=MX3(C0[0],C0[1],C1[0]),b=MX3(C0[2],C0[3],C1[1]); a=MX3(a,C1[2],C1[3]); \
      _Pragma("unroll") for(int r=4;r<16;r+=4){a=MX3(a,C0[r],C0[r+1]);b=MX3(b,C0[r+2],C0[r+3]);a=MX3(a,C1[r],C1[r+1]);b=MX3(b,C1[r+2],C1[r+3]);} \
      float rm=__builtin_fmaxf(a,b); { auto rr=__builtin_amdgcn_permlane32_swap(__float_as_uint(rm),__float_as_uint(rm),false,false); rm=__builtin_fmaxf(__uint_as_float(rr[0]),__uint_as_float(rr[1])); } \
      resc=false; \
      if(__builtin_expect(__any(rm>(float)THRL),0)){ const float dl=__builtin_fmaxf(rm,0.f); mhat+=dl; \
        _Pragma("unroll") for(int r=0;r<16;++r){C0[r]-=dl;C1[r]-=dl;} \
        SETM(); \
        const float f=__builtin_amdgcn_exp2f(-dl); l_reg*=f; if(hi==0)wsf[r32]=f; resc=true; } } \
    SBAR(); \
    GAPB(o[0]=__builtin_amdgcn_mfma_f32_32x32x16_bf16(PAF(0),VFR(0),o[0],0,0,0), C0,0); \
    GAPB(o[1]=__builtin_amdgcn_mfma_f32_32x32x16_bf16(PAF(0),VFR(4),o[1],0,0,0), C0,4); \
    KRD(GL,0); GAPB(o[0]=__builtin_amdgcn_mfma_f32_32x32x16_bf16(PAF(1),VFR(1),o[0],0,0,0), C0,8); \
    KRD(GL,1); GAPB(o[1]=__builtin_amdgcn_mfma_f32_32x32x16_bf16(PAF(1),VFR(5),o[1],0,0,0), C0,12); \
    KRD(GL,2); GAPB(o[0]=__builtin_amdgcn_mfma_f32_32x32x16_bf16(PAF(2),VFR(2),o[0],0,0,0), C1,0); \
    KRD(GL,3); GAPB(o[1]=__builtin_amdgcn_mfma_f32_32x32x16_bf16(PAF(2),VFR(6),o[1],0,0,0), C1,4); \
    GAPB(o[0]=__builtin_amdgcn_mfma_f32_32x32x16_bf16(PAF(3),VFR(3),o[0],0,0,0), C1,8); \
    GAPB(o[1]=__builtin_amdgcn_mfma_f32_32x32x16_bf16(PAF(3),VFR(7),o[1],0,0,0), C1,12); \
    }while(0)
  int t=1;
  #undef CMASK
  #define CMASK(P0,P1,t) do{}while(0)
  for(;t+5<NT;t+=2){
    STEP(pB0,pB1,pA0,pA1,t,true,true,true);     WAIT_BAR(2); RESC(); ROT();
    STEP(pA0,pA1,pB0,pB1,t+1,true,true,true);   WAIT_BAR(2); RESC(); ROT();
  }
  #undef CMASK
  #define CMASK(P0,P1,t) do{int jb_=(t)-(NT-4); if(jb_>=0)cmask(P0,P1,jb_,qrel,hi);}while(0)
  #define ENDW(tt) do{ if((tt)+3<NT){WAIT_BAR(2);} else if((tt)+2<NT){WAIT_BAR(1);} else {WAIT_BAR(0);} }while(0)
  for(;t+1<NT;t+=2){
    STEP(pB0,pB1,pA0,pA1,t,(t+3<NT),(t+1<NT),(t+1<NT));       ENDW(t);   RESC(); ROT();
    STEP(pA0,pA1,pB0,pB1,t+1,(t+4<NT),(t+2<NT),(t+2<NT));     ENDW(t+1); RESC(); ROT();
  }
  STEP(pB0,pB1,pA0,pA1,NT-1,false,false,false); RESC();
  { float sacc=pB0[0]+pB0[1]; _Pragma("unroll") for(int r=2;r<16;++r)sacc+=pB0[r]; _Pragma("unroll") for(int r=0;r<16;++r)sacc+=pB1[r]; l_reg+=sacc;
    pw0=(u32x4){PKW(pB0,0),PKW(pB0,2),PKW(pB0,4),PKW(pB0,6)};pw1=(u32x4){PKW(pB0,8),PKW(pB0,10),PKW(pB0,12),PKW(pB0,14)};pw2=(u32x4){PKW(pB1,0),PKW(pB1,2),PKW(pB1,4),PKW(pB1,6)};pw3=(u32x4){PKW(pB1,8),PKW(pB1,10),PKW(pB1,12),PKW(pB1,14)};
    SBAR(); pv(o,vb0+sl_cur,PAF(0),PAF(1),PAF(2),PAF(3)); }
  #undef PKW
  #undef PAF
  #undef VFR
  #undef PIN
  #undef MX3
  #undef GAPA
  #undef GAPB
  #undef EX
  #undef VRD
  #undef KRD
  #undef STEP
  #undef ENDW
  {auto rr=__builtin_amdgcn_permlane32_swap(__float_as_uint(l_reg),__float_as_uint(l_reg),false,false);l_reg=__uint_as_float(rr[0])+__uint_as_float(rr[1]);}
  if(hi==0)wsf[32+r32]=l_reg;asm volatile("s_waitcnt lgkmcnt(0)":::"memory");
  float rli[16];
  #pragma unroll
  for(int r=0;r<16;++r)rli[r]=__builtin_amdgcn_rcpf(wsf[32+crow(r,hi)]);
  bf16*Ow=O+(rowbase+q0+wid*QBLK)*DM+h*D;
  { bf16*stg=(bf16*)(shm+LDS_OST)+wid*2048;
    #pragma unroll
    for(int r=0;r<16;++r){const int orow=crow(r,hi);
      #pragma unroll
      for(int d0=0;d0<2;++d0)stg[orow*64+d0*32+r32]=__float2bfloat16(o[d0][r]*rli[r]);}
    asm volatile("s_waitcnt lgkmcnt(0)":::"memory");
    #pragma unroll
    for(int i=0;i<4;++i){const int row=i*8+(lane>>3),ch=lane&7; const u32x4 v=*(const u32x4*)(stg+row*64+ch*8); ATTN_STORE16(Ow+(long)row*DM+ch*8,v);} }
  asm volatile("s_waitcnt lgkmcnt(0)\n\ts_barrier":::"memory");
  #undef DMA_K
  #undef DMA_V
  #undef CMASK
  #undef START
  #undef RESC
  #undef ROT
  #undef KXLD
  #undef QX
  #undef SETM
}
constexpr int ATTN_LDS_BYTES=LDS_BYTES;
struct AttnTensors { const bf16* Q; const bf16* K; const bf16* V; bf16* O; };
struct AttnUnit { int bh; int qb; };
struct StaticOrder {
  int vcu;
  __device__ __forceinline__ explicit StaticOrder(int v):vcu(v){}
  __device__ __forceinline__ bool next(int i,AttnUnit&u)const{ if(i>=4)return false; const int s=vcu&1; u.bh=vcu>>1; u.qb=(i==0)?7-s:(i==1)?4+s:(i==2)?3-s:s; return true; }
  __device__ __forceinline__ void a_ready(const AttnUnit&)const{}
  __device__ __forceinline__ void done(const AttnUnit&)const{}
};
template<class Sched,int THRL=8> __device__ __forceinline__ void attn_phase(char*lds,const AttnTensors&T,const Sched&S,lds_cptr btab,lds_cptr zblk){
  AttnUnit u;
  for(int i=0;S.next(i,u);++i){ S.a_ready(u); attn_unit<THRL>(u.bh/NHEAD,u.bh%NHEAD,u.qb,T.Q,T.K,T.V,T.O,lds,btab,zblk); S.done(u); }
}
#undef SBAR
#undef WAIT_BAR
}
#define XB_TMO      128
#define XB_XCNT(j)  (256  + 64 * (j))
#define XB_XSUB(j)  (1280 + 64 * (j))
#define XB_XGEN(j)  (2304 + 64 * (j))
#define XB_TOP      3328
#define XB_TOPGEN   3392
#define XCD_BAR_WORDS 3456
#define XB_SPIN_CAP (1u << 18)

__device__ __forceinline__ unsigned xb_ld(unsigned* p)              { return __hip_atomic_load(p, __ATOMIC_RELAXED, __HIP_MEMORY_SCOPE_AGENT); }
__device__ __forceinline__ unsigned xb_add(unsigned* p, unsigned v) { return __hip_atomic_fetch_add(p, v, __ATOMIC_RELAXED, __HIP_MEMORY_SCOPE_AGENT); }
__device__ __forceinline__ unsigned xb_xcc_id() { return (unsigned)__builtin_amdgcn_s_getreg((3 << 11) | 20) & 0xFu; }
#define XB_SPIN(cond, bar) do { unsigned _sp = 0; while (cond) { __builtin_amdgcn_s_sleep(1); \
    if ((++_sp & 255u) == 0u) { if (xb_ld(&(bar)[XB_TMO])) break; if (_sp > XB_SPIN_CAP) { atomicAdd(&(bar)[XB_TMO], 1u); break; } } } } while (0)

struct XcdBarrier {
    unsigned* bar; unsigned x;
    volatile LAS unsigned* st;
};

__device__ __forceinline__ XcdBarrier xcd_barrier_post(unsigned* bar, volatile LAS unsigned* st) {
    XcdBarrier b; b.bar = bar; b.x = xb_xcc_id(); b.st = st;
    if (threadIdx.x == 0) (void)xb_add(&bar[XB_XCNT(b.x)], 1u);
    return b;
}
__device__ __forceinline__ void xcd_barrier_complete(unsigned* bar, unsigned x, unsigned& nloc, unsigned& nx) {
    const unsigned G = gridDim.x * gridDim.y * gridDim.z;
    unsigned sum, cnt, mine, sp = 0u;
    for (;;) {
        sum = 0u; cnt = 0u; mine = 0u;
#pragma unroll
        for (unsigned j = 0; j < 16; ++j) { const unsigned c = xb_ld(&bar[XB_XCNT(j)]); sum += c; cnt += (c > 0u) ? 1u : 0u; mine = (j == x) ? c : mine; }
        if (sum == G) break;
        __builtin_amdgcn_s_sleep(1);
        if ((++sp & 255u) == 0u) { if (xb_ld(&bar[XB_TMO])) break; if (sp > XB_SPIN_CAP) { atomicAdd(&bar[XB_TMO], 1u); break; } }
    }
    nloc = mine > 0u ? mine : 1u; nx = cnt > 0u ? cnt : 1u;
}

__device__ __forceinline__ void xcd_barrier(const XcdBarrier& b) {
    asm volatile("s_waitcnt vmcnt(0)" ::: "memory");
    __syncthreads();
    if (threadIdx.x == 0) {
        unsigned* bar = b.bar;
        __builtin_amdgcn_s_waitcnt(0);
        unsigned nloc = b.st[0], nx = b.st[1];
        if (nloc == 0u) { xcd_barrier_complete(bar, b.x, nloc, nx); b.st[0] = nloc; b.st[1] = nx; }
        const unsigned old = xb_add(&bar[XB_XSUB(b.x)], 1u);
        const unsigned gen = old / nloc;
        if (old + 1u == (gen + 1u) * nloc) {
            __builtin_amdgcn_fence(__ATOMIC_RELEASE, "agent");
            asm volatile("s_waitcnt vmcnt(0)" ::: "memory");
            const unsigned og = xb_add(&bar[XB_TOP], 1u);
            const unsigned tg = og / nx;
            if (og + 1u == (tg + 1u) * nx) xb_add(&bar[XB_TOPGEN], 1u);
            else XB_SPIN(xb_ld(&bar[XB_TOPGEN]) == tg, bar);
            __builtin_amdgcn_fence(__ATOMIC_ACQUIRE, "agent");
            xb_add(&bar[XB_XGEN(b.x)], 1u);
            asm volatile("s_waitcnt vmcnt(0)" ::: "memory");
        } else {
            XB_SPIN(xb_ld(&bar[XB_XGEN(b.x)]) == gen, bar);
            __builtin_amdgcn_fence(__ATOMIC_ACQUIRE, "agent");
            asm volatile("s_waitcnt vmcnt(0)" ::: "memory");
        }
    }
    __syncthreads();
}

struct Frame {
    LAS unsigned char* lds;
    volatile LAS unsigned* MISC;
    gu32* ctl;
    int tid, lane, wave, vcu, G;
    const float *x_p, *x_s, *state_conv, *cache_k, *cache_v, *cache_lf, *norm_ffn, *ffn_w_in, *ffn_w_out, *norm_mix, *conv_w_in, *conv_w, *conv_w_out, *attn_w_in, *attn_bf, *q_norm, *k_norm, *attn_w_out;
    float* out; unsigned char* ws;
};
__device__ __forceinline__ bf16* ws_bf(const Frame& F, size_t off) { return (bf16*)(F.ws + off); }

__device__ __forceinline__ float wave_sum(float v) {
#pragma unroll
    for (int o = 1; o < 64; o <<= 1) v += __shfl_xor(v, o);
    return v;
}

__device__ __forceinline__ void wprep_item(const float* W, int ldw, int K, const float* gain, int col0, int nvalid, bf16* WT, int dst_row0, int kb, LAS float* scr, int lane) {
    const int k0 = 64 * kb, c = lane & 31;
#pragma unroll 8
    for (int i = 0; i < 32; ++i) { const int kk = 2 * i + (lane >> 5); float v = 0.f; if (c < nvalid) v = W[(size_t)(k0 + kk) * ldw + col0 + c]; if (gain) v *= gain[k0 + kk]; scr[kk * 33 + c] = v; }
    LDS_WAIT(); asm volatile("" ::: "memory");
    const int c8 = lane & 7;
#pragma unroll
    for (int j = 0; j < 4; ++j) { const int n = (lane >> 3) + 8 * j; const LAS float* s = scr + (8 * c8) * 33 + n;
        v4u o; o.x = pk2(s[0 * 33], s[1 * 33]); o.y = pk2(s[2 * 33], s[3 * 33]); o.z = pk2(s[4 * 33], s[5 * 33]); o.w = pk2(s[6 * 33], s[7 * 33]);
        *(GAS v4u*)(WT + (size_t)(dst_row0 + n) * K + k0 + 8 * c8) = o; }
    LDS_WAIT(); asm volatile("" ::: "memory");
}
__device__ __forceinline__ int pair_col(int g, int base, int half_off) { const int tile = g >> 3, bj = (g >> 2) & 1, i = g & 3; return base + bj * half_off + 128 * tile + 32 * i; }
__device__ __forceinline__ int head_col(int g) { const int tile = g >> 3, bj = (g >> 2) & 1, wc = g & 3; return 256 * tile + 64 * wc + 32 * bj; }

__device__ __forceinline__ void p0_prologue(Frame& F) {
    LAS float* scr = (LAS float*)(F.lds + RING_OFF + F.wave * 16384);
    const int gw = F.vcu * NWAVES + F.wave, NGW = F.G * NWAVES, lane = F.lane;
    constexpr int KB1 = D / 64, KB2 = FF / 64;
    constexpr int I_FFI = (2 * FF / 32) * KB1, I_FFO = (D / 32) * KB2;
    constexpr int I_CI1 = 32 * KB1, I_CI2 = 64 * KB1, I_CO = 32 * KB1, I_AQK = 64 * KB1, I_AV = 32 * KB1, I_AF = 8 * KB1, I_AO = 32 * KB1;
    constexpr int NITEMS = 4 * I_FFI + 4 * I_FFO + I_CI1 + I_CI2 + I_CO + I_AQK + I_AV + I_AF + I_AO;
    for (int it = gw; it < NITEMS; it += NGW) {
        int r = it;
        if (r < 4 * I_FFI) { const int w = r / I_FFI; r -= w * I_FFI; const int g = r / KB1, kb = r % KB1;
            wprep_item(F.ffn_w_in + (size_t)w * D * 2 * FF, 2 * FF, D, F.norm_ffn + w * D, pair_col(g, 0, FF), 32, ws_bf(F, WS_FFI + w * SZ_FFI), 32 * g, kb, scr, lane); continue; }
        r -= 4 * I_FFI;
        if (r < 4 * I_FFO) { const int w = r / I_FFO; r -= w * I_FFO; const int g = r / KB2, kb = r % KB2;
            wprep_item(F.ffn_w_out + (size_t)w * FF * D, D, FF, nullptr, 32 * g, 32, ws_bf(F, WS_FFO + w * SZ_FFO), 32 * g, kb, scr, lane); continue; }
        r -= 4 * I_FFO;
        if (r < I_CI1) { const int g = r / KB1, kb = r % KB1; wprep_item(F.conv_w_in, 3 * D, D, F.norm_mix, 32 * g, 32, ws_bf(F, WS_CI), 32 * g, kb, scr, lane); continue; }
        r -= I_CI1;
        if (r < I_CI2) { const int g = r / KB1, kb = r % KB1; wprep_item(F.conv_w_in, 3 * D, D, F.norm_mix, pair_col(g, D, D), 32, ws_bf(F, WS_CI), D + 32 * g, kb, scr, lane); continue; }
        r -= I_CI2;
        if (r < I_CO) { const int g = r / KB1, kb = r % KB1; wprep_item(F.conv_w_out, D, D, nullptr, 32 * g, 32, ws_bf(F, WS_CO), 32 * g, kb, scr, lane); continue; }
        r -= I_CO;
        if (r < I_AQK) { const int g = r / KB1, kb = r % KB1; wprep_item(F.attn_w_in, 3 * D + NH, D, F.norm_mix + D, head_col(g), 32, ws_bf(F, WS_AI), 32 * g, kb, scr, lane); continue; }
        r -= I_AQK;
        if (r < I_AV) { const int g = r / KB1, kb = r % KB1; wprep_item(F.attn_w_in, 3 * D + NH, D, F.norm_mix + D, 2 * D + 32 * g, 32, ws_bf(F, WS_AI), 2 * D + 32 * g, kb, scr, lane); continue; }
        r -= I_AV;
        if (r < I_AF) { const int g = r / KB1, kb = r % KB1; wprep_item(F.attn_w_in, 3 * D + NH, D, F.norm_mix + D, 3 * D, g == 0 ? NH : 0, ws_bf(F, WS_AI), 3 * D + 32 * g, kb, scr, lane); continue; }
        r -= I_AF;
        { const int g = r / KB1, kb = r % KB1; wprep_item(F.attn_w_out, D, D, nullptr, 32 * g, 32, ws_bf(F, WS_AO), 32 * g, kb, scr, lane); }
    }
    bf16* XB = ws_bf(F, WS_XB); float* RS = (float*)(F.ws + WS_RS);
    for (int m = gw; m < M; m += NGW) {
        const float* src = m < MP ? F.x_p + (size_t)m * D : F.x_s + (size_t)(m - MP) * D;
        const GAS pg8::f32x4* xr = (const GAS pg8::f32x4*)src + lane; float ss = 0.f;
        GAS unsigned long long* o8 = (GAS unsigned long long*)(XB + (size_t)m * D) + lane;
#pragma unroll
        for (int j = 0; j < 4; ++j) { const pg8::f32x4 v = xr[64 * j]; ss += (v[0] * v[0] + v[1] * v[1]) + (v[2] * v[2] + v[3] * v[3]);
            o8[64 * j] = (unsigned long long)pk2(v[0], v[1]) | ((unsigned long long)pk2(v[2], v[3]) << 32); }
        ss = wave_sum(ss);
        if (m < MP) { if (lane == 0) *(pg8::f32x4*)(RS + (size_t)m * 4) = (pg8::f32x4){ss, 0.f, 0.f, 0.f}; }
        else if (lane < 4) *(pg8::f32x4*)(RS + (size_t)MP * 4 + (size_t)(m - MP) * 16 + 4 * lane) = (pg8::f32x4){lane == 0 ? ss : 0.f, 0.f, 0.f, 0.f};
    }
}

__device__ __forceinline__ void unpack8(const v4u w, float (&f)[8]) { f[0] = bflo(w.x); f[1] = bfhi(w.x); f[2] = bflo(w.y); f[3] = bfhi(w.y); f[4] = bflo(w.z); f[5] = bfhi(w.z); f[6] = bflo(w.w); f[7] = bfhi(w.w); }
__device__ __forceinline__ void conv_ew_phase(Frame& F) {
    bf16* G = ws_bf(F, WS_BIG); const bf16* U = ws_bf(F, WS_BIG + SZ_ACT);
    const int gw = F.vcu * NWAVES + F.wave, NGW = F.G * NWAVES, lane = F.lane;
    constexpr int RCH = 16, NITEMS = (M / RCH) * 2;
    for (int it = gw; it < NITEMS; it += NGW) {
        const int r0 = (it >> 1) * RCH, c = (it & 1) * 512 + lane * 8;
        float w0[8], w1[8], w2[8], um2[8], um1[8];
#pragma unroll
        for (int j = 0; j < 8; ++j) { w0[j] = F.conv_w[c + j]; w1[j] = F.conv_w[D + c + j]; w2[j] = F.conv_w[2 * D + c + j]; }
        int t0, b; bool prompt = r0 < MP;
        if (prompt) { t0 = r0 & (SEQ - 1); b = r0 >> 11; } else { t0 = (r0 - MP) & (DSEQ - 1); b = (r0 - MP) >> 6; }
        if (t0 == 0) {
            if (prompt) {
#pragma unroll
                for (int j = 0; j < 8; ++j) { um2[j] = 0.f; um1[j] = 0.f; }
            } else {
#pragma unroll
                for (int j = 0; j < 8; ++j) { um2[j] = F.state_conv[((size_t)b * 2 + 0) * D + c + j]; um1[j] = F.state_conv[((size_t)b * 2 + 1) * D + c + j]; }
            }
        } else {
            unpack8(*(const GAS v4u*)(U + (size_t)(r0 - 2) * D + c), um2); unpack8(*(const GAS v4u*)(U + (size_t)(r0 - 1) * D + c), um1);
        }
        for (int i = 0; i < RCH; ++i) {
            float uc[8], gg[8], z[8];
            unpack8(*(const GAS v4u*)(U + (size_t)(r0 + i) * D + c), uc); unpack8(*(const GAS v4u*)(G + (size_t)(r0 + i) * D + c), gg);
#pragma unroll
            for (int j = 0; j < 8; ++j) { z[j] = gg[j] * (w0[j] * um2[j] + w1[j] * um1[j] + w2[j] * uc[j]); um2[j] = um1[j]; um1[j] = uc[j]; }
            v4u o; o.x = pk2(z[0], z[1]); o.y = pk2(z[2], z[3]); o.z = pk2(z[4], z[5]); o.w = pk2(z[6], z[7]);
            *(GAS v4u*)(G + (size_t)(r0 + i) * D + c) = o;
        }
    }
}

template <int FMT  >
__device__ __forceinline__ void cumsum_table(const float* s1, int n1, const float* s2, int n2, LAS float* tab, LAS float* wsum, int tid) {
    asm volatile("" : "+v"(tid));
    const int lane = tid & 63, wid = tid >> 6;
    float v[5]; float run = 0.f;
#pragma unroll
    for (int j = 0; j < 5; ++j) { const int e = 5 * tid + j; float x = 0.f; if (e < n1) x = s1[(size_t)e * NH]; else if (e < n1 + n2) x = s2[(size_t)(e - n1) * NH]; run += x; v[j] = run; }
    float sc = run;
#pragma unroll
    for (int o = 1; o < 64; o <<= 1) { const float t = __shfl_up(sc, o); if (lane >= o) sc += t; }
    if (lane == 63) wsum[wid] = sc;
    __syncthreads();
    float off = 0.f;
    for (int w = 0; w < wid; ++w) off += wsum[w];
    const float excl = off + sc - run;
#pragma unroll
    for (int j = 0; j < 5; ++j) { const int e = 5 * tid + j; if (e < n1 + n2) { const float bias = -(excl + v[j]) * LOG2E;
        if (FMT == 0) tab[e] = bias;
        else { const float hb = 0.5f * bias;
               const unsigned p1 = f2bf(hb); const float r1 = hb - bf2f((unsigned short)p1); const unsigned p2 = f2bf(r1); const float r2 = r1 - bf2f((unsigned short)p2); const unsigned p3 = f2bf(r2);
            ((LAS v4u*)tab)[e] = (v4u){p1 | (p2 << 16), p3 | 0x3F800000u, 0x3F803F80u, 0u}; } } }
    __syncthreads();
}

__device__ __forceinline__ void attn_simple_phase(Frame& F, bool do_prompt) {
    bf16* Qb = ws_bf(F, WS_BIG); const bf16* Kb = ws_bf(F, WS_BIG + SZ_ACT); const bf16* Vb = ws_bf(F, WS_BIG + 2 * SZ_ACT);
    LAS float* tab = (LAS float*)(F.lds + RING_OFF); LAS float* wsum = (LAS float*)(F.lds + RING_OFF + 16384);
    const int lane = F.lane;
    for (int bh = F.vcu >> 1; bh < NB * NH; bh += F.G >> 1) {
        const int b = bh >> 4, h = bh & 15, half = F.vcu & 1;
        __syncthreads();
        if (do_prompt) cumsum_table<0>(F.out + O_LFP + (size_t)b * SEQ * NH + h, SEQ, nullptr, 0, tab, wsum, F.tid);
        for (int i = F.wave; do_prompt && i < 16; i += NWAVES) {
            const int tb = 2 * i + half, t = tb * 64 + lane; const size_t row = (size_t)b * SEQ + t;
            float q[64], o[64];
#pragma unroll
            for (int d = 0; d < 64; d += 8) { float f[8]; unpack8(*(const GAS v4u*)(Qb + row * D + h * HD + d), f);
#pragma unroll
                for (int j = 0; j < 8; ++j) { q[d + j] = f[j]; o[d + j] = 0.f; } }
            float mx = -1e30f, l = 0.f;
            const int kend = tb * 64 + 63;
            for (int k = 0; k <= kend; ++k) {
                const size_t kr = ((size_t)b * SEQ + k) * D + h * HD;
                float s = 0.f;
#pragma unroll
                for (int d = 0; d < 64; d += 8) { float f[8]; unpack8(*(const GAS v4u*)(Kb + kr + d), f);
#pragma unroll
                    for (int j = 0; j < 8; ++j) s += q[d + j] * f[j]; }
                s += tab[k];
                if (k > t) s = -1e30f;
                const float mn = fmaxf(mx, s), al = __builtin_amdgcn_exp2f(mx - mn), p = (k > t) ? 0.f : __builtin_amdgcn_exp2f(s - mn);
                mx = mn; l = l * al + p;
#pragma unroll
                for (int d = 0; d < 64; d += 8) { float f[8]; unpack8(*(const GAS v4u*)(Vb + kr + d), f);
#pragma unroll
                    for (int j = 0; j < 8; ++j) o[d + j] = o[d + j] * al + p * f[j]; }
            }
            const float il = 1.0f / l;
#pragma unroll
            for (int d = 0; d < 64; d += 8) { v4u w; w.x = pk2(o[d] * il, o[d + 1] * il); w.y = pk2(o[d + 2] * il, o[d + 3] * il); w.z = pk2(o[d + 4] * il, o[d + 5] * il); w.w = pk2(o[d + 6] * il, o[d + 7] * il);
                *(GAS v4u*)(Qb + row * D + h * HD + d) = w; }
        }
        if (half == 0) {
            __syncthreads();
            cumsum_table<0>(F.cache_lf + (size_t)b * PAST * NH + h, PAST, F.out + O_LFS + (size_t)b * DSEQ * NH + h, DSEQ, tab, wsum, F.tid);
            if (F.wave == 0) {
                const int t = lane; const size_t row = (size_t)MP + (size_t)b * DSEQ + t;
                float q[64], o[64];
#pragma unroll
                for (int d = 0; d < 64; d += 8) { float f[8]; unpack8(*(const GAS v4u*)(Qb + row * D + h * HD + d), f);
#pragma unroll
                    for (int j = 0; j < 8; ++j) { q[d + j] = f[j]; o[d + j] = 0.f; } }
                float mx = -1e30f, l = 0.f;
                for (int k = 0; k < PAST; ++k) {
                    const float* kp = F.cache_k + (((size_t)b * PAST + k) * NH + h) * HD; const float* vp = F.cache_v + (((size_t)b * PAST + k) * NH + h) * HD;
                    float s = 0.f;
#pragma unroll
                    for (int d = 0; d < 64; d += 4) { const pg8::f32x4 f = *(const GAS pg8::f32x4*)(kp + d); s += q[d] * f[0] + q[d + 1] * f[1] + q[d + 2] * f[2] + q[d + 3] * f[3]; }
                    s += tab[k];
                    const float mn = fmaxf(mx, s), al = __builtin_amdgcn_exp2f(mx - mn), p = __builtin_amdgcn_exp2f(s - mn);
                    mx = mn; l = l * al + p;
#pragma unroll
                    for (int d = 0; d < 64; d += 4) { const pg8::f32x4 f = *(const GAS pg8::f32x4*)(vp + d); o[d] = o[d] * al + p * f[0]; o[d + 1] = o[d + 1] * al + p * f[1]; o[d + 2] = o[d + 2] * al + p * f[2]; o[d + 3] = o[d + 3] * al + p * f[3]; }
                }
                for (int k = 0; k < DSEQ; ++k) {
                    const size_t kr = ((size_t)MP + (size_t)b * DSEQ + k) * D + h * HD;
                    float s = 0.f;
#pragma unroll
                    for (int d = 0; d < 64; d += 8) { float f[8]; unpack8(*(const GAS v4u*)(Kb + kr + d), f);
#pragma unroll
                        for (int j = 0; j < 8; ++j) s += q[d + j] * f[j]; }
                    s += tab[PAST + k];
                    if (k > t) s = -1e30f;
                    const float mn = fmaxf(mx, s), al = __builtin_amdgcn_exp2f(mx - mn), p = (k > t) ? 0.f : __builtin_amdgcn_exp2f(s - mn);
                    mx = mn; l = l * al + p;
#pragma unroll
                    for (int d = 0; d < 64; d += 8) { float f[8]; unpack8(*(const GAS v4u*)(Vb + kr + d), f);
#pragma unroll
                        for (int j = 0; j < 8; ++j) o[d + j] = o[d + j] * al + p * f[j]; }
                }
                const float il = 1.0f / l;
#pragma unroll
                for (int d = 0; d < 64; d += 8) { v4u w; w.x = pk2(o[d] * il, o[d + 1] * il); w.y = pk2(o[d + 2] * il, o[d + 3] * il); w.z = pk2(o[d + 4] * il, o[d + 5] * il); w.w = pk2(o[d + 6] * il, o[d + 7] * il);
                    *(GAS v4u*)(Qb + row * D + h * HD + d) = w; }
            }
        }
    }
    __syncthreads();
}

__device__ __forceinline__ void attn_fast_phase(Frame& F, unsigned char* lds_generic, bf16* Oout) {
    constexpr int BT_OFF = 86016, ZB_OFF = BT_OFF + 32768, WS_OFF = ZB_OFF + 1024;
    static_assert(attn_body::ATTN_LDS_BYTES <= BT_OFF && WS_OFF + 64 <= RING_BYTES, "attention LDS map");
    const attn_body::AttnTensors AT{(const attn_body::bf16*)ws_bf(F, WS_BIG), (const attn_body::bf16*)ws_bf(F, WS_BIG + SZ_ACT), (const attn_body::bf16*)ws_bf(F, WS_BIG + 2 * SZ_ACT), (attn_body::bf16*)Oout};
    for (int v = F.vcu; v < 2 * NB * NH; v += F.G) {
        const int bh = v >> 1, b = bh >> 4, h = bh & 15;
        __syncthreads();
        if (F.tid < 256) ((LAS unsigned*)(F.lds + ZB_OFF))[F.tid] = 0u;
        cumsum_table<1>(F.out + O_LFP + (size_t)b * SEQ * NH + h, SEQ, nullptr, 0, (LAS float*)(F.lds + BT_OFF), (LAS float*)(F.lds + WS_OFF), F.tid);
        const attn_body::StaticOrder S(v);
        attn_body::attn_phase<attn_body::StaticOrder>((char*)lds_generic + RING_OFF, AT, S, (attn_body::lds_cptr)(F.lds + BT_OFF), (attn_body::lds_cptr)(F.lds + ZB_OFF));
    }
}

typedef float sa_f32x16 __attribute__((ext_vector_type(16)));
__device__ __forceinline__ int sa_crow(int r, int hi) { return (r & 3) + 8 * (r >> 2) + 4 * hi; }
__device__ __forceinline__ unsigned sa_pk(float lo, float hi) { return pg8::cvt_pk_bf16(lo, hi); }
__device__ __forceinline__ void sa_tile(sa_f32x16& o0, sa_f32x16& o1, float& m, float& l, const pg8::bf16x8 (&qf)[4], const pg8::bf16x8 (&kf)[4], const pg8::bf16x8 (&vf)[2][2],
                                        const LAS float* tabk, int hi, int tq, int kn0) {
    sa_f32x16 p = {};
#pragma unroll
    for (int s = 0; s < 4; ++s) p = __builtin_amdgcn_mfma_f32_32x32x16_bf16(kf[s], qf[s], p, 0, 0, 0);
#pragma unroll
    for (int g = 0; g < 4; ++g) { const pg8::f32x4 bb = *(const LAS pg8::f32x4*)(tabk + 8 * g + 4 * hi);
#pragma unroll
        for (int j = 0; j < 4; ++j) p[4 * g + j] += bb[j]; }
    if (kn0 >= 0) {
#pragma unroll
        for (int r = 0; r < 16; ++r) if (kn0 + sa_crow(r, hi) > tq) p[r] = -1e30f;
    }
    float rm = p[0];
#pragma unroll
    for (int r = 1; r < 16; ++r) rm = fmaxf(rm, p[r]);
    rm = fmaxf(rm, __shfl_xor(rm, 32));
    const float mn = fmaxf(m, rm), al = __builtin_amdgcn_exp2f(m - mn);
    m = mn;
    float ls = 0.f;
#pragma unroll
    for (int r = 0; r < 16; ++r) { p[r] = __builtin_amdgcn_exp2f(p[r] - mn); ls += p[r]; }
    l = l * al + ls;
#pragma unroll
    for (int r = 0; r < 16; ++r) { o0[r] *= al; o1[r] *= al; }
    pg8::u32x4 w0, w1;
    w0.x = sa_pk(p[0], p[1]); w0.y = sa_pk(p[2], p[3]); w0.z = sa_pk(p[4], p[5]); w0.w = sa_pk(p[6], p[7]);
    w1.x = sa_pk(p[8], p[9]); w1.y = sa_pk(p[10], p[11]); w1.z = sa_pk(p[12], p[13]); w1.w = sa_pk(p[14], p[15]);
    const pg8::bf16x8 pf0 = __builtin_bit_cast(pg8::bf16x8, w0), pf1 = __builtin_bit_cast(pg8::bf16x8, w1);
    o0 = __builtin_amdgcn_mfma_f32_32x32x16_bf16(vf[0][0], pf0, o0, 0, 0, 0); o1 = __builtin_amdgcn_mfma_f32_32x32x16_bf16(vf[0][1], pf0, o1, 0, 0, 0);
    o0 = __builtin_amdgcn_mfma_f32_32x32x16_bf16(vf[1][0], pf1, o0, 0, 0, 0); o1 = __builtin_amdgcn_mfma_f32_32x32x16_bf16(vf[1][1], pf1, o1, 0, 0, 0);
}
__device__ __forceinline__ void attn_sample_fast(Frame& F, bf16* Oout) {
    constexpr int OW_OFF = 0, ML_OFF = 65536, TAB_OFF = ML_OFF + 2048, WS_OFF = TAB_OFF + 8704;
    static_assert(WS_OFF + 64 <= RING_BYTES, "decode attention LDS map");
    bf16* Qb = ws_bf(F, WS_BIG); const bf16* Kb = ws_bf(F, WS_BIG + SZ_ACT); const bf16* Vb = ws_bf(F, WS_BIG + 2 * SZ_ACT);
    int lane = F.lane; asm volatile("" : "+v"(lane));
    const int r32 = lane & 31, hi = lane >> 5, w = F.wave;
    LAS float* tab = (LAS float*)(F.lds + TAB_OFF);
    LAS float* ow = (LAS float*)(F.lds + OW_OFF);
    LAS float* mw = (LAS float*)(F.lds + ML_OFF);
    for (int v = F.vcu; v < 2 * NB * NH; v += F.G) {
        const int bh = v >> 1, qblk = v & 1, b = bh >> 4, h = bh & 15;
        __syncthreads();
        cumsum_table<0>(F.cache_lf + (size_t)b * PAST * NH + h, PAST, F.out + O_LFS + (size_t)b * DSEQ * NH + h, DSEQ, tab, (LAS float*)(F.lds + WS_OFF), F.tid);
        const size_t srow0 = (size_t)MP + (size_t)b * DSEQ;
        pg8::bf16x8 qf[4];
#pragma unroll
        for (int s = 0; s < 4; ++s) qf[s] = *(const pg8::bf16x8*)(Qb + (srow0 + 32 * qblk + r32) * D + h * HD + 16 * s + 8 * hi);
        sa_f32x16 o0 = {}, o1 = {}; float m = -1e30f, l = 0.f;
        const float* kbase = F.cache_k + (((size_t)b * PAST + r32) * NH + h) * HD + 8 * hi;
        const float* vbase = F.cache_v + (((size_t)b * PAST + 4 * hi) * NH + h) * HD + r32;
        pg8::f32x4 kr[4][2]; float vr[2][2][8];
        { const int key0 = 32 * (8 * w);
#pragma unroll
          for (int s = 0; s < 4; ++s) { kr[s][0] = *(const GAS pg8::f32x4*)(kbase + (size_t)key0 * D + 16 * s); kr[s][1] = *(const GAS pg8::f32x4*)(kbase + (size_t)key0 * D + 16 * s + 4); }
#pragma unroll
          for (int s = 0; s < 2; ++s)
#pragma unroll
            for (int j = 0; j < 8; ++j) { const float* vp = vbase + (size_t)(key0 + 16 * s + 8 * (j >> 2) + (j & 3)) * D; vr[s][0][j] = vp[0]; vr[s][1][j] = vp[32]; } }
        for (int i = 0; i < 8; ++i) {
            const int key0 = 32 * (8 * w + i);
            pg8::bf16x8 kf[4], vf[2][2];
#pragma unroll
            for (int s = 0; s < 4; ++s) { pg8::u32x4 t; t.x = sa_pk(kr[s][0][0], kr[s][0][1]); t.y = sa_pk(kr[s][0][2], kr[s][0][3]); t.z = sa_pk(kr[s][1][0], kr[s][1][1]); t.w = sa_pk(kr[s][1][2], kr[s][1][3]); kf[s] = __builtin_bit_cast(pg8::bf16x8, t); }
#pragma unroll
            for (int s = 0; s < 2; ++s)
#pragma unroll
                for (int d = 0; d < 2; ++d) { pg8::u32x4 t; t.x = sa_pk(vr[s][d][0], vr[s][d][1]); t.y = sa_pk(vr[s][d][2], vr[s][d][3]); t.z = sa_pk(vr[s][d][4], vr[s][d][5]); t.w = sa_pk(vr[s][d][6], vr[s][d][7]); vf[s][d] = __builtin_bit_cast(pg8::bf16x8, t); }
            if (i + 1 < 8) { const int kn = key0 + 32;
#pragma unroll
                for (int s = 0; s < 4; ++s) { kr[s][0] = *(const GAS pg8::f32x4*)(kbase + (size_t)kn * D + 16 * s); kr[s][1] = *(const GAS pg8::f32x4*)(kbase + (size_t)kn * D + 16 * s + 4); }
#pragma unroll
                for (int s = 0; s < 2; ++s)
#pragma unroll
                    for (int j = 0; j < 8; ++j) { const float* vp = vbase + (size_t)(kn + 16 * s + 8 * (j >> 2) + (j & 3)) * D; vr[s][0][j] = vp[0]; vr[s][1][j] = vp[32]; } }
            sa_tile(o0, o1, m, l, qf, kf, vf, tab + key0, hi, 0, -1);
        }
        if (w <= qblk) {
            const int nt = w; pg8::bf16x8 kf[4], vf[2][2];
#pragma unroll
            for (int s = 0; s < 4; ++s) kf[s] = *(const pg8::bf16x8*)(Kb + (srow0 + 32 * nt + r32) * D + h * HD + 16 * s + 8 * hi);
#pragma unroll
            for (int s = 0; s < 2; ++s)
#pragma unroll
                for (int d = 0; d < 2; ++d) { unsigned short e[8];
#pragma unroll
                    for (int j = 0; j < 8; ++j) e[j] = Vb[(srow0 + 32 * nt + 16 * s + 8 * (j >> 2) + 4 * hi + (j & 3)) * D + h * HD + 32 * d + r32];
                    pg8::u32x4 t; t.x = e[0] | ((unsigned)e[1] << 16); t.y = e[2] | ((unsigned)e[3] << 16); t.z = e[4] | ((unsigned)e[5] << 16); t.w = e[6] | ((unsigned)e[7] << 16); vf[s][d] = __builtin_bit_cast(pg8::bf16x8, t); }
            sa_tile(o0, o1, m, l, qf, kf, vf, tab + PAST + 32 * nt, hi, 32 * qblk + r32, 32 * nt);
        }
        l += __shfl_xor(l, 32);
        if (hi == 0) { mw[w * 32 + r32] = m; mw[256 + w * 32 + r32] = l; }
#pragma unroll
        for (int r = 0; r < 16; ++r) { const int d = sa_crow(r, hi); ow[(w * 64 + d) * 32 + r32] = o0[r]; ow[(w * 64 + 32 + d) * 32 + r32] = o1[r]; }
        __syncthreads();
        { const int q = F.tid & 31, d0 = (F.tid >> 5) * 4;
          float mm = mw[q]; float sc[8];
#pragma unroll
          for (int ww = 1; ww < 8; ++ww) mm = fmaxf(mm, mw[ww * 32 + q]);
          float L = 0.f;
#pragma unroll
          for (int ww = 0; ww < 8; ++ww) { sc[ww] = __builtin_amdgcn_exp2f(mw[ww * 32 + q] - mm); L += mw[256 + ww * 32 + q] * sc[ww]; }
          const float il = 1.0f / L; float acc[4] = {0.f, 0.f, 0.f, 0.f};
#pragma unroll
          for (int ww = 0; ww < 8; ++ww)
#pragma unroll
              for (int dd = 0; dd < 4; ++dd) acc[dd] += ow[(ww * 64 + d0 + dd) * 32 + q] * sc[ww];
          v2u o; o.x = pk2(acc[0] * il, acc[1] * il); o.y = pk2(acc[2] * il, acc[3] * il);
          *(GAS v2u*)(Oout + (srow0 + 32 * qblk + q) * D + h * HD + d0) = o; }
    }
    __syncthreads();
}

template <int K, int NN>
__device__ __forceinline__ void small_tile_mma(const bf16* A, int row0, const bf16* Bt, int g0, int g1, LAS float* part, int wave, int lane) {
    constexpr int KS = K / 8, NST = KS / 32;
    const int fr = lane & 15, fq = lane >> 4;
    const bf16* ap = A + (size_t)(row0 + fr) * K + wave * KS + 8 * fq;
    const bf16* bp0 = Bt + (size_t)(g0 + fr) * K + wave * KS + 8 * fq;
    const bf16* bp1 = Bt + (size_t)(g1 + fr) * K + wave * KS + 8 * fq;
    pg8::f32x4 acc[2][NN];
#pragma unroll
    for (int m = 0; m < 2; ++m)
#pragma unroll
        for (int n = 0; n < NN; ++n) acc[m][n] = (pg8::f32x4){0.f, 0.f, 0.f, 0.f};
#pragma unroll 4
    for (int st = 0; st < NST; ++st) {
        pg8::bf16x8 a[2], b[NN];
        a[0] = *(const pg8::bf16x8*)(ap + st * 32); a[1] = *(const pg8::bf16x8*)(ap + (size_t)16 * K + st * 32);
#pragma unroll
        for (int n = 0; n < NN; ++n) b[n] = *(const pg8::bf16x8*)((n < 2 ? bp0 + (size_t)(16 * n) * K : bp1 + (size_t)(16 * (n - 2)) * K) + st * 32);
#pragma unroll
        for (int m = 0; m < 2; ++m)
#pragma unroll
            for (int n = 0; n < NN; ++n) acc[m][n] = __builtin_amdgcn_mfma_f32_16x16x32_bf16(b[n], a[m], acc[m][n], 0, 0, 0);
    }
    __syncthreads();
#pragma unroll
    for (int m = 0; m < 2; ++m)
#pragma unroll
        for (int n = 0; n < NN; ++n) *(LAS pg8::f32x4*)(part + ((wave * 32 + 16 * m + fr) * 64 + 16 * n + 4 * fq)) = acc[m][n];
    __syncthreads();
}
__device__ __forceinline__ pg8::f32x4 sm_sum(const LAS float* part, int row, int col) {
    pg8::f32x4 s = *(const LAS pg8::f32x4*)(part + row * 64 + col);
#pragma unroll
    for (int w = 1; w < 8; ++w) s += *(const LAS pg8::f32x4*)(part + (w * 32 + row) * 64 + col);
    return s;
}
__device__ __forceinline__ float row16_sum(float v) { v += __shfl_xor(v, 1); v += __shfl_xor(v, 2); v += __shfl_xor(v, 4); v += __shfl_xor(v, 8); return v; }
__device__ __forceinline__ v2u pk4(const pg8::f32x4 v) { v2u o; o.x = pg8::cvt_pk_bf16(v[0], v[1]); o.y = pg8::cvt_pk_bf16(v[2], v[3]); return o; }

template <int K, bool BASE_F32, bool OUT_F32>
__device__ __forceinline__ void small_out_proj(Frame& F, const bf16* A, const bf16* Bt, const float* base_s, float scale) {
    LAS float* part = (LAS float*)(F.lds + RING_OFF);
    float* X = F.out + O_Y; bf16* XB = ws_bf(F, WS_XB); float* RSs = (float*)(F.ws + WS_RS) + (size_t)MP * 4;
    for (int t = F.vcu; t < 256; t += F.G) {
        const int rg = t >> 4, ct = t & 15, row0 = MP + 32 * rg;
        small_tile_mma<K, 4>(A, row0, Bt, 64 * ct, 64 * ct + 32, part, F.wave, F.lane);
        const int rl = F.tid >> 4, q = F.tid & 15, row = row0 + rl, col = 64 * ct + 4 * q;
        const pg8::f32x4 a = sm_sum(part, rl, 4 * q);
        pg8::f32x4 b;
        if (BASE_F32) b = *(const pg8::f32x4*)(base_s + (size_t)(row - MP) * D + col);
        else { const v2u wb = *(const v2u*)(XB + (size_t)row * D + col); b = (pg8::f32x4){bflo(wb.x), bfhi(wb.x), bflo(wb.y), bfhi(wb.y)}; }
        const pg8::f32x4 v = b + a * scale;
        if (OUT_F32) *(pg8::f32x4*)(X + (size_t)row * D + col) = v;
        else {
            *(v2u*)(XB + (size_t)row * D + col) = pk4(v);
            const float ss = row16_sum((v[0] * v[0] + v[1] * v[1]) + (v[2] * v[2] + v[3] * v[3]));
            if (q == 0) RSs[(size_t)(row - MP) * 16 + ct] = ss;
        }
    }
    __syncthreads();
}
__device__ __forceinline__ void small_conv_in(Frame& F) {
    LAS float* part = (LAS float*)(F.lds + RING_OFF);
    const bf16* XB = ws_bf(F, WS_XB); const bf16* Bt = ws_bf(F, WS_CI); bf16* G = ws_bf(F, WS_BIG); bf16* U = ws_bf(F, WS_BIG + SZ_ACT); const float* RS = (const float*)(F.ws + WS_RS);
    for (int t = F.vcu; t < 768; t += F.G) {
        const int rl = F.tid >> 4, q = F.tid & 15;
        if (t < 256) {
            const int rg = t >> 4, ct = t & 15, row0 = MP + 32 * rg, row = row0 + rl;
            small_tile_mma<D, 4>(XB, row0, Bt, 64 * ct, 64 * ct + 32, part, F.wave, F.lane);
            const float r = mk::row_rstd(RS, row);
            *(v2u*)(G + (size_t)row * D + 64 * ct + 4 * q) = pk4(sm_sum(part, rl, 4 * q) * r);
        } else {
            const int tt = t - 256, rg = tt >> 5, j = tt & 31, row0 = MP + 32 * rg, row = row0 + rl, g0 = D + 256 * (j >> 2) + 32 * (j & 3);
            small_tile_mma<D, 4>(XB, row0, Bt, g0, g0 + 128, part, F.wave, F.lane);
            if (q < 8) {
                const float r = mk::row_rstd(RS, row);
                const pg8::f32x4 u = sm_sum(part, rl, 4 * q) * sm_sum(part, rl, 32 + 4 * q) * (r * r);
                const int col = 32 * j + 4 * q;
                *(v2u*)(U + (size_t)row * D + col) = pk4(u);
                const int rr = row - MP, tq = rr & (DSEQ - 1);
                if (tq >= DSEQ - 2) *(pg8::f32x4*)(F.out + O_CSS + ((size_t)(rr >> 6) * 2 + (tq - (DSEQ - 2))) * D + col) = u;
            }
        }
    }
    __syncthreads();
}
__device__ __forceinline__ void small_attn_in(Frame& F) {
    LAS float* part = (LAS float*)(F.lds + RING_OFF);
    const bf16* XB = ws_bf(F, WS_XB); const bf16* Bt = ws_bf(F, WS_AI); const float* RS = (const float*)(F.ws + WS_RS);
    bf16* Qb = ws_bf(F, WS_BIG); bf16* Kb = ws_bf(F, WS_BIG + SZ_ACT); bf16* Vb = ws_bf(F, WS_BIG + 2 * SZ_ACT);
    constexpr int NT_S = 16 * 48, NT_F = M / 32;
    for (int t = F.vcu; t < NT_S + NT_F; t += F.G) {
        const int rl = F.tid >> 4, q = F.tid & 15;
        if (t < NT_S) {
            const int rg = t / 48, c = t % 48, row0 = MP + 32 * rg, row = row0 + rl;
            if (c < 32) {
                const bool isq = c < 16; const int hh = c & 15, g0 = 256 * ((isq ? 0 : 4) + (hh >> 2)) + 32 * (hh & 3);
                small_tile_mma<D, 4>(XB, row0, Bt, g0, g0 + 128, part, F.wave, F.lane);
                const float r = mk::row_rstd(RS, row);
                const pg8::f32x4 a = sm_sum(part, rl, 4 * q);
                const float ss = row16_sum((a[0] * a[0] + a[1] * a[1]) + (a[2] * a[2] + a[3] * a[3]));
                const float f = r * rsqrtf(r * r * ss * (1.0f / HD) + NORM_EPS);
                const pg8::f32x4 gv = *(const pg8::f32x4*)((isq ? F.q_norm : F.k_norm) + 4 * q), o = a * f * gv;
                const size_t off = (size_t)row * D + hh * HD + 4 * q;
                if (isq) *(v2u*)(Qb + off) = pk4(o * QSCALE);
                else { *(v2u*)(Kb + off) = pk4(o); *(pg8::f32x4*)(F.out + O_KS + (size_t)(row - MP) * D + hh * HD + 4 * q) = o; }
            } else {
                const int ct = c - 32;
                small_tile_mma<D, 4>(XB, row0, Bt, 2 * D + 64 * ct, 2 * D + 64 * ct + 32, part, F.wave, F.lane);
                const float r = mk::row_rstd(RS, row);
                const pg8::f32x4 o = sm_sum(part, rl, 4 * q) * r;
                *(v2u*)(Vb + (size_t)row * D + 64 * ct + 4 * q) = pk4(o);
                *(pg8::f32x4*)(F.out + O_VS + (size_t)(row - MP) * D + 64 * ct + 4 * q) = o;
            }
        } else {
            const int row0 = 32 * (t - NT_S), row = row0 + rl;
            small_tile_mma<D, 1>(XB, row0, Bt, 3 * D, 3 * D, part, F.wave, F.lane);
            if (q < 4) {
                const float r = mk::row_rstd(RS, row);
                const pg8::f32x4 a = sm_sum(part, rl, 4 * q) * r + *(const pg8::f32x4*)(F.attn_bf + 4 * q);
                pg8::f32x4 lf;
#pragma unroll
                for (int j = 0; j < 4; ++j) lf[j] = mk::log_sigmoid(a[j]);
                float* lo = row < MP ? F.out + O_LFP + (size_t)row * NH : F.out + O_LFS + (size_t)(row - MP) * NH;
                *(pg8::f32x4*)(lo + 4 * q) = lf;
            }
        }
    }
    __syncthreads();
}

template <class Epi, class Sched>
__device__ __forceinline__ void run_gemm(Frame& F, const pg8::Gemm& g, const Sched& S, const Epi& E) {
#if MK_FAST_GEMM
    pg8::gemm_phase<Epi, Sched, Epi::AFTER_DRAIN ? false : PG8_ALIGN, PG8_SP2>(F.lds + RING_OFF, g, S, E);
#else
    mk::gemm_phase_simple<Epi, Sched>(F.lds + RING_OFF, g, S, E);
#endif
}
template <int K, bool BASE_F32, bool OUT_F32>
__device__ __forceinline__ void out_proj_phase(Frame& F, const bf16* A, const bf16* Bt, const float* base_p, const float* base_s, float scale) {
    float* X = F.out + O_Y;
    pg8::Gemm g{A, Bt, MP, D, K};
    mk::EpiRes<BASE_F32, OUT_F32> E{base_p, base_s, X, ws_bf(F, WS_XB), (float*)(F.ws + WS_RS), scale};
    const int nunits = (MP / 256) * (D / 256);
    for (int rnd = 0; rnd * F.G < nunits; ++rnd) {
        mk::RoundOrder S; S.init(MP, D, F.G, (int)blockIdx.x); S.rnd = rnd;
        run_gemm(F, g, S, E);
        __syncthreads();
    }
    small_out_proj<K, BASE_F32, OUT_F32>(F, A, Bt, base_s, scale);
}
__device__ __forceinline__ void ffn_in_phase(Frame& F, int w) {
    pg8::Gemm g{ws_bf(F, WS_XB), ws_bf(F, WS_FFI + (size_t)w * SZ_FFI), M, 2 * FF, D};
    pg8::StaticOrder S; S.init(M, 2 * FF, F.G, (int)blockIdx.x);
    mk::EpiSwiglu E{ws_bf(F, WS_H), (const float*)(F.ws + WS_RS)};
    run_gemm(F, g, S, E);
}

struct Args { const float* in[18]; float* out; unsigned char* ws; int ph_lo, ph_hi; };
__global__ void __launch_bounds__(NWAVES * 64, 2) mk_fwd(Args args) {
    extern __shared__ __attribute__((aligned(16))) unsigned char lds[];
    Frame F;
    F.lds = (LAS unsigned char*)lds;
    F.MISC = (volatile LAS unsigned*)(F.lds + MISC_OFF);
    F.tid = threadIdx.x; F.lane = F.tid & 63; F.wave = __builtin_amdgcn_readfirstlane(F.tid >> 6);
    F.G = gridDim.x; { const int bx = blockIdx.x; F.vcu = (F.G % 8 == 0) ? (bx % 8) * (F.G / 8) + bx / 8 : bx; }
    F.ws = args.ws; F.out = args.out; F.ctl = (gu32*)(args.ws + WS_CTL);
    F.x_p = args.in[0]; F.x_s = args.in[1]; F.state_conv = args.in[2]; F.cache_k = args.in[3]; F.cache_v = args.in[4]; F.cache_lf = args.in[5];
    F.norm_ffn = args.in[6]; F.ffn_w_in = args.in[7]; F.ffn_w_out = args.in[8]; F.norm_mix = args.in[9]; F.conv_w_in = args.in[10]; F.conv_w = args.in[11];
    F.conv_w_out = args.in[12]; F.attn_w_in = args.in[13]; F.attn_bf = args.in[14]; F.q_norm = args.in[15]; F.k_norm = args.in[16]; F.attn_w_out = args.in[17];
    for (int u = F.tid; u < (LDS_BYTES - LDSCTL_OFF) / 4; u += NWAVES * 64) ((LAS unsigned*)(F.lds + LDSCTL_OFF))[u] = 0u;
    __syncthreads();
#if MK_ONE_LAUNCH
    XcdBarrier bar = xcd_barrier_post((unsigned*)(F.ctl + CW_BAR), F.MISC + 8);
#define GRID_BAR() xcd_barrier(bar)
#else
#define GRID_BAR() do {} while (0)
#endif
    const int lo = args.ph_lo, hi = args.ph_hi;
#define IN(k) (lo <= (k) && (k) < hi)
#define SEAM(k) do { if (IN(k) && IN((k) + 1)) GRID_BAR(); } while (0)

#define PH(k, ...) if (IN(k)) { for (int rep_ = ((k) == MK_PROBE ? MK_PROBE_REPS : 0); rep_ >= 0; --rep_) { const bool extra_ = rep_ > 0; (void)extra_; \
        { int t_ = threadIdx.x; asm volatile("" : "+v"(t_)); F.tid = t_; F.lane = t_ & 63; F.wave = __builtin_amdgcn_readfirstlane(t_ >> 6); }     \
        __VA_ARGS__; if (extra_) GRID_BAR(); } } SEAM(k)
    PH(0, p0_prologue(F); VM_WAIT(); __syncthreads());
    PH(1, ffn_in_phase(F, 0));
    PH(2, out_proj_phase<FF, true, false>(F, ws_bf(F, WS_H), ws_bf(F, WS_FFO + 0 * SZ_FFO), F.x_p, F.x_s, 0.5f));
    PH(3, {
        pg8::Gemm g{ws_bf(F, WS_XB), ws_bf(F, WS_CI), MP, 3 * D, D};
        pg8::StaticOrder S; S.init(MP, 3 * D, F.G, (int)blockIdx.x);
        mk::EpiConvIn E{ws_bf(F, WS_BIG), ws_bf(F, WS_BIG + SZ_ACT), (const float*)(F.ws + WS_RS), F.out + O_CSP, F.out + O_CSS};
        run_gemm(F, g, S, E);
        __syncthreads();
        small_conv_in(F);
    });
    PH(4, conv_ew_phase(F));
    PH(5, out_proj_phase<D, false, false>(F, ws_bf(F, WS_BIG), ws_bf(F, WS_CO), nullptr, nullptr, extra_ ? 0.f : 1.0f));
    PH(6, ffn_in_phase(F, 1));
    PH(7, out_proj_phase<FF, false, false>(F, ws_bf(F, WS_H), ws_bf(F, WS_FFO + 1 * SZ_FFO), nullptr, nullptr, extra_ ? 0.f : 0.5f));
    PH(8, ffn_in_phase(F, 2));
    PH(9, out_proj_phase<FF, false, false>(F, ws_bf(F, WS_H), ws_bf(F, WS_FFO + 2 * SZ_FFO), nullptr, nullptr, extra_ ? 0.f : 0.5f));
    PH(10, {
        pg8::Gemm g{ws_bf(F, WS_XB), ws_bf(F, WS_AI), MP, 3 * D, D};
        pg8::StaticOrder S; S.init(MP, 3 * D, F.G, (int)blockIdx.x);
        mk::EpiAttnIn E{ws_bf(F, WS_BIG), ws_bf(F, WS_BIG + SZ_ACT), ws_bf(F, WS_BIG + 2 * SZ_ACT), (const float*)(F.ws + WS_RS), F.q_norm, F.k_norm, F.attn_bf,
                        F.out + O_KP, F.out + O_KS, F.out + O_VP, F.out + O_VS, F.out + O_LFP, F.out + O_LFS};
        run_gemm(F, g, S, E);
        __syncthreads();
        small_attn_in(F);
    });
#if MK_FAST_ATTN
    PH(11, { bf16* Oo = extra_ ? ws_bf(F, WS_END) : ws_bf(F, WS_BIG); if (MK_PROBE != 11 || MK_PROBE_REPS < 100 || !extra_) attn_fast_phase(F, lds, Oo); if (MK_PROBE != 11 || MK_PROBE_REPS >= 100 || !extra_) attn_sample_fast(F, Oo); });
#else
    PH(11, attn_simple_phase(F, true));
#endif
    PH(12, out_proj_phase<D, false, false>(F, ws_bf(F, WS_BIG), ws_bf(F, WS_AO), nullptr, nullptr, extra_ ? 0.f : 1.0f));
    PH(13, ffn_in_phase(F, 3));
    PH(14, out_proj_phase<FF, false, true>(F, ws_bf(F, WS_H), ws_bf(F, WS_FFO + 3 * SZ_FFO), nullptr, nullptr, 0.5f));
    if (MK_PROBE == 100) for (int rep_ = 0; rep_ < MK_PROBE_REPS; ++rep_) GRID_BAR();
#undef PH
#undef IN
#undef SEAM
}

extern "C" void kernel_launch(void* const* d_in, const int* in_sizes, int n_in, void* d_out, int out_size, void* d_ws, size_t ws_size, hipStream_t stream) {
    static int grid = 0;
    if (grid == 0) {
        if (n_in != 18 || in_sizes[0] != MP * D || (size_t)out_size != O_END || ws_size < WS_END) {
            fprintf(stderr, "kernel_launch: unexpected problem: n_in %d in0 %d out %d ws %zu; nothing launched\n", n_in, n_in > 0 ? in_sizes[0] : -1, out_size, ws_size); grid = -1; return; }
        int dev = 0, cus = 0, per_cu = 0;
        if (hipGetDevice(&dev) != hipSuccess || hipDeviceGetAttribute(&cus, hipDeviceAttributeMultiprocessorCount, dev) != hipSuccess) { grid = -1; return; }
        if (hipFuncSetAttribute((const void*)mk_fwd, hipFuncAttributeMaxDynamicSharedMemorySize, LDS_BYTES) != hipSuccess) { fprintf(stderr, "kernel_launch: hipFuncSetAttribute failed\n"); grid = -1; return; }
        if (hipOccupancyMaxActiveBlocksPerMultiprocessor(&per_cu, (const void*)mk_fwd, NWAVES * 64, LDS_BYTES) != hipSuccess || per_cu < 1)
            fprintf(stderr, "kernel_launch: note: occupancy query reports %d workgroups per CU\n", per_cu);
        (void)hipGetLastError();
        grid = cus;
    }
    if (grid < 0) return;
    if (hipMemsetAsync((char*)d_ws + WS_CTL, 0, CTL_ZERO_BYTES, stream) != hipSuccess) return;
    Args a{};
    for (int i = 0; i < 18; ++i) a.in[i] = (const float*)d_in[i];
    a.out = (float*)d_out; a.ws = (unsigned char*)d_ws;
#if MK_ONE_LAUNCH
    a.ph_lo = 0; a.ph_hi = NPH;
    hipLaunchKernelGGL(mk_fwd, dim3(grid), dim3(NWAVES * 64), LDS_BYTES, stream, a);
#else
    for (int p = 0; p < NPH; ++p) { a.ph_lo = p; a.ph_hi = p + 1; hipLaunchKernelGGL(mk_fwd, dim3(grid), dim3(NWAVES * 64), LDS_BYTES, stream, a); }
#endif
}
```

```cpp
#include <hip/hip_runtime.h>
#include <hip/hip_bf16.h>
#include <cstdio>
#include <cstdint>
#include <cmath>

#ifndef MK_ONE_LAUNCH
#define MK_ONE_LAUNCH 1
#endif
#ifndef MK_FAST_GEMM
#define MK_FAST_GEMM 1
#endif
#ifndef MK_FAST_ATTN
#define MK_FAST_ATTN 1
#endif

#ifndef MK_PROBE
#define MK_PROBE -1
#endif
#ifndef MK_PROBE_REPS
#define MK_PROBE_REPS 0
#endif

constexpr int D = 1024, NH = 16, HD = 64, FF = 2816, SEQ = 2048, NB = 8, DSEQ = 64, PAST = 2048;
constexpr int MP = NB * SEQ, MS = NB * DSEQ, M = MP + MS;
constexpr int NAI = 3328;
constexpr float NORM_EPS = 1e-6f, LOG2E = 1.4426950408889634f;
constexpr float QSCALE = 0.125f * LOG2E;

constexpr size_t O_Y = 0;
constexpr size_t O_CSP = (size_t)M * D;
constexpr size_t O_CSS = O_CSP + (size_t)NB * 2 * D;
constexpr size_t O_KP = O_CSS + (size_t)NB * 2 * D;
constexpr size_t O_VP = O_KP + (size_t)MP * D;
constexpr size_t O_LFP = O_VP + (size_t)MP * D;
constexpr size_t O_KS = O_LFP + (size_t)MP * NH;
constexpr size_t O_VS = O_KS + (size_t)MS * D;
constexpr size_t O_LFS = O_VS + (size_t)MS * D;
constexpr size_t O_END = O_LFS + (size_t)MS * NH;

constexpr size_t MiB = 1u << 20;
constexpr size_t WS_CTL = 0, CTL_ZERO_BYTES = 1 * MiB;
constexpr size_t SZ_FFI = (size_t)2 * FF * D * 2, SZ_FFO = (size_t)D * FF * 2;
constexpr size_t WS_FFI = 1 * MiB;
constexpr size_t WS_FFO = WS_FFI + 4 * SZ_FFI;
constexpr size_t WS_CI = WS_FFO + 4 * SZ_FFO;
constexpr size_t WS_CO = WS_CI + (size_t)3 * D * D * 2;
constexpr size_t WS_AI = WS_CO + (size_t)D * D * 2;
constexpr size_t WS_AO = WS_AI + (size_t)NAI * D * 2;
constexpr size_t WS_XB = WS_AO + (size_t)D * D * 2;
constexpr size_t WS_RS = WS_XB + (size_t)M * D * 2;
constexpr size_t WS_BIG = ((WS_RS + (size_t)MP * 16 + (size_t)MS * 64 + MiB - 1) / MiB) * MiB;
constexpr size_t SZ_ACT = (size_t)M * D * 2;
constexpr size_t WS_H = WS_BIG;
constexpr size_t WS_END = WS_BIG + 3 * SZ_ACT;
static_assert(WS_END <= 256 * MiB && (size_t)M * FF * 2 <= 3 * SZ_ACT, "d_ws map");
constexpr int CW_TMO = 0, CW_CODE = 1, CW_BAR = 4096;

constexpr int RING_OFF = 0, RING_BYTES = 131072, LDSCTL_OFF = RING_BYTES, MISC_OFF = LDSCTL_OFF + 320, LDS_BYTES = 147456;
constexpr int NWAVES = 8;
constexpr int NPH = 15;

#define GAS __attribute__((address_space(1)))
#define LAS __attribute__((address_space(3)))
typedef unsigned short bf16;
typedef unsigned v4u __attribute__((ext_vector_type(4)));
typedef unsigned v2u __attribute__((ext_vector_type(2)));
typedef GAS unsigned gu32;
#define RLX_AGENT __ATOMIC_RELAXED, __HIP_MEMORY_SCOPE_AGENT
#define LDS_WAIT() asm volatile("s_waitcnt lgkmcnt(0)" ::: "memory")
#define VM_WAIT() asm volatile("s_waitcnt vmcnt(0)" ::: "memory")
__device__ __forceinline__ unsigned f2bf(float f) { unsigned u = __builtin_bit_cast(unsigned, f); return (u + 0x7fffu + ((u >> 16) & 1u)) >> 16; }
__device__ __forceinline__ unsigned pk2(float lo, float hi) { return f2bf(lo) | (f2bf(hi) << 16); }
__device__ __forceinline__ float bf2f(unsigned short h) { return __builtin_bit_cast(float, (unsigned)h << 16); }
__device__ __forceinline__ float bflo(unsigned w) { return __builtin_bit_cast(float, w << 16); }
__device__ __forceinline__ float bfhi(unsigned w) { return __builtin_bit_cast(float, w & 0xffff0000u); }

namespace pg8 {
#define PG8_LAS __attribute__((address_space(3)))
typedef unsigned short bf16_t;
typedef short bf16x8 __attribute__((ext_vector_type(8)));
typedef float f32x4 __attribute__((ext_vector_type(4)));
typedef unsigned u32x4 __attribute__((ext_vector_type(4)));
constexpr int BM = 256, BK = 64, HALF = 128, HTB = HALF * BK * 2  , STAGE_BYTES = 8 * HTB, NXCD = 8, WGM = 8;

__host__ __device__ __forceinline__ int lds_byte(int r, int c) { const int st = (r >> 4) * 2 + (c >> 5), rr = r & 15, cc = c & 31, ob = rr * 64 + cc * 2; return st * 1024 + (ob ^ (((ob >> 9) & 1) << 5)); }
__host__ __device__ __forceinline__ void stage_rc(int b, int& R, int& C) { const int st = b / 1024, sb = b % 1024, swz = sb ^ (((sb >> 9) & 1) << 5); R = (st >> 1) * 16 + swz / 64; C = (st & 1) * 32 + (swz % 64) / 2; }
__host__ __device__ __forceinline__ int perm32(int rho) { const int n = rho >> 4, i = rho & 15; return 8 * (i >> 2) + 4 * n + (i & 3); }

struct Unit { int pm, pn; };
struct Gemm { const bf16_t* A; const bf16_t* Bt; int M, N, K; };

struct StaticOrder {
    int nM, nN, nwg, G, c;
    __host__ __device__ void init(int M, int N, int G_, int c_) { nM = M / BM; nN = N / BM; nwg = nM * nN; G = G_; c = c_; }
    __host__ __device__ bool next(int i, Unit& u) const {
        const long L = (long)i * G + c; if (L >= nwg) return false;
        int wgid = (int)L; { const int q = nwg / NXCD, r = nwg % NXCD, xcd = wgid % NXCD, off = wgid / NXCD; wgid = (xcd < r ? xcd * (q + 1) : r * (q + 1) + (xcd - r) * q) + off; }
        const int nig = WGM * nN, gid = wgid / nig, fm = gid * WGM, gsz = (nM - fm) < WGM ? (nM - fm) : WGM;
        u.pm = fm + ((wgid % nig) % gsz); u.pn = (wgid % nig) / gsz; return true;
    }
    __device__ __forceinline__ void a_ready(const Unit&) const {}
    __device__ __forceinline__ void done(const Unit&) const {}
};

__device__ __forceinline__ unsigned cvt_pk_bf16(float lo, float hi) { unsigned r; asm volatile("v_cvt_pk_bf16_f32 %0, %1, %2" : "=v"(r) : "v"(lo), "v"(hi)); return r; }
template <class Epi, class Sched, bool ALIGN_EPI = false, bool SP2 = false>
__device__ __forceinline__ void gemm_phase(PG8_LAS unsigned char* lds, const Gemm g, const Sched& S, const Epi& E) {
    int tid = threadIdx.x; asm volatile("" : "+v"(tid));
    const int wid = __builtin_amdgcn_readfirstlane(tid >> 6), lane = tid & 63, wr = wid >> 2, wc = wid & 3, fr = lane & 15, fq = lane >> 4;
    const int K = g.K, nt = K / BK;
    unsigned voffA[2], voffB[2];
#pragma unroll
    for (int i = 0; i < 2; ++i) { int R, C; stage_rc(tid * 16 + i * 8192, R, C); const int Rb = Epi::PERM ? ((R & ~31) + perm32(R & 31)) : R;
        voffA[i] = (unsigned)(R * K + C) * 2u; voffB[i] = (unsigned)(Rb * K + C) * 2u; }
    const size_t kstep = (size_t)(BK * 2);
    const size_t hstep = (size_t)HALF * K * 2;
    const size_t tstep = 2 * hstep;
    const unsigned ldsw = (unsigned)wid * 1024u;
    const int aoff = lds_byte(wr * 64 + fr, fq * 8), boff = lds_byte(wc * 32 + fr, fq * 8);
#define PG8_SA(b, h) (((b) * 2 + (h)) * HTB)
#define PG8_SB(b, h) ((4 + (b) * 2 + (h)) * HTB)
#define PG8_STAGE(bufoff, gbase, voff) do { _Pragma("unroll") for (int _i = 0; _i < 2; ++_i) \
        __builtin_amdgcn_global_load_lds((const unsigned*)((const char*)(gbase) + (voff)[_i]), (PG8_LAS unsigned*)(lds + (bufoff) + ldsw + _i * 8192), 16, 0, 0); } while (0)
#define PG8_LDA(dst, b, h) do { _Pragma("unroll") for (int m = 0; m < 4; ++m) _Pragma("unroll") for (int k = 0; k < 2; ++k) dst[m][k] = *(const PG8_LAS bf16x8*)(lds + PG8_SA(b, h) + aoff + m * 2048 + k * 1024); } while (0)
#define PG8_LDB(dst, b, h) do { _Pragma("unroll") for (int n = 0; n < 2; ++n) _Pragma("unroll") for (int k = 0; k < 2; ++k) dst[n][k] = *(const PG8_LAS bf16x8*)(lds + PG8_SB(b, h) + boff + n * 2048 + k * 1024); } while (0)
#define PG8_MMA(ai, bj, At, Bt) do { __builtin_amdgcn_s_setprio(1); _Pragma("unroll") for (int m = 0; m < 4; ++m) _Pragma("unroll") for (int n = 0; n < 2; ++n) _Pragma("unroll") for (int k = 0; k < 2; ++k) \
        acc[ai][bj][m][n] = __builtin_amdgcn_mfma_f32_16x16x32_bf16(Bt[n][k], At[m][k], acc[ai][bj][m][n], 0, 0, 0); __builtin_amdgcn_s_setprio(0); } while (0)
#define PG8_WAIT_V(n) asm volatile("s_waitcnt vmcnt(" #n ")" ::: "memory")
#define PG8_WAIT_L(n) asm volatile("s_waitcnt lgkmcnt(" #n ")" ::: "memory")
#define PG8_BAR __builtin_amdgcn_s_barrier()
#define PG8_SCHED __builtin_amdgcn_sched_barrier(0)
    Unit cur, nxt; int ui = 0;
    if (!S.next(0, cur)) return;
    f32x4 acc[2][2][4][2];
#pragma unroll
    for (int a = 0; a < 2; ++a)
#pragma unroll
        for (int b = 0; b < 2; ++b)
#pragma unroll
            for (int m = 0; m < 4; ++m)
#pragma unroll
                for (int n = 0; n < 2; ++n) acc[a][b][m][n] = (f32x4){0.f, 0.f, 0.f, 0.f};
    bf16x8 At[4][2], B0[2][2], B1[2][2];
    const char* cA = (const char*)g.A + (size_t)cur.pm * tstep; const char* cB = (const char*)g.Bt + (size_t)cur.pn * tstep;
    S.a_ready(cur);
    if constexpr (SP2) {
        PG8_STAGE(PG8_SB(0, 0), cB, voffB); PG8_STAGE(PG8_SB(0, 1), cB + hstep, voffB); PG8_STAGE(PG8_SA(0, 0), cA, voffA); PG8_STAGE(PG8_SA(0, 1), cA + hstep, voffA);
        if (wr == 1) PG8_BAR;
        PG8_WAIT_V(2); PG8_BAR;
        PG8_STAGE(PG8_SB(1, 0), cB + kstep, voffB); PG8_STAGE(PG8_SA(1, 0), cA + kstep, voffA); PG8_STAGE(PG8_SB(1, 1), cB + hstep + kstep, voffB);
        PG8_WAIT_V(6); PG8_BAR;
    } else {
        PG8_STAGE(PG8_SB(0, 0), cB, voffB); PG8_STAGE(PG8_SA(0, 0), cA, voffA); PG8_STAGE(PG8_SB(0, 1), cB + hstep, voffB); PG8_STAGE(PG8_SA(0, 1), cA + hstep, voffA);
        if (wr == 1) PG8_BAR;
        PG8_WAIT_V(4); PG8_BAR;
        PG8_STAGE(PG8_SB(1, 0), cB + kstep, voffB); PG8_STAGE(PG8_SA(1, 0), cA + kstep, voffA); PG8_STAGE(PG8_SB(1, 1), cB + hstep + kstep, voffB);
        PG8_WAIT_V(6); PG8_BAR;
    }
    for (;;) {
        const bool has_next = S.next(ui + 1, nxt);
        const char* nA = has_next ? (const char*)g.A + (size_t)nxt.pm * tstep : cA; const char* nB = has_next ? (const char*)g.Bt + (size_t)nxt.pn * tstep : cB;
        for (int t = 0; t < nt; t += 2) {
            const bool last = (t == nt - 2);
            const char* a1 = cA + (size_t)(t + 1) * kstep;
            const char* a2 = last ? nA : cA + (size_t)(t + 2) * kstep; const char* b2 = last ? nB : cB + (size_t)(t + 2) * kstep;
            const char* a3 = a2 + kstep; const char* b3 = b2 + kstep;
            if (last && has_next) S.a_ready(nxt);
            if constexpr (SP2) {
            PG8_LDB(B0, 0, 0); PG8_LDB(B1, 0, 1); PG8_SCHED; PG8_LDA(At, 0, 0); PG8_STAGE(PG8_SA(1, 1), a1 + hstep, voffA);
            PG8_WAIT_V(8); PG8_WAIT_L(0); PG8_BAR; PG8_MMA(0, 0, At, B0); PG8_MMA(0, 1, At, B1); PG8_BAR; PG8_SCHED;
            PG8_LDA(At, 0, 1); PG8_STAGE(PG8_SB(0, 0), b2, voffB); PG8_STAGE(PG8_SB(0, 1), b2 + hstep, voffB); PG8_STAGE(PG8_SA(0, 0), a2, voffA);
            PG8_WAIT_V(8); PG8_WAIT_L(0); PG8_BAR; PG8_MMA(1, 0, At, B0); PG8_MMA(1, 1, At, B1); PG8_BAR; PG8_SCHED;
            PG8_LDB(B0, 1, 0); PG8_LDB(B1, 1, 1); PG8_SCHED; PG8_LDA(At, 1, 0); PG8_STAGE(PG8_SA(0, 1), a2 + hstep, voffA);
            PG8_WAIT_V(8); PG8_WAIT_L(0); PG8_BAR; PG8_MMA(0, 0, At, B0); PG8_MMA(0, 1, At, B1); PG8_BAR; PG8_SCHED;
            PG8_LDA(At, 1, 1); PG8_STAGE(PG8_SB(1, 0), b3, voffB); PG8_STAGE(PG8_SB(1, 1), b3 + hstep, voffB); PG8_STAGE(PG8_SA(1, 0), a3, voffA);
            PG8_WAIT_V(8); PG8_WAIT_L(0); PG8_BAR; PG8_MMA(1, 0, At, B0); PG8_MMA(1, 1, At, B1); PG8_BAR; PG8_SCHED;
            } else {
            PG8_LDB(B0, 0, 0); PG8_SCHED; PG8_LDA(At, 0, 0); PG8_STAGE(PG8_SA(1, 1), a1 + hstep, voffA);
            PG8_WAIT_L(8); PG8_BAR; PG8_WAIT_L(0); PG8_MMA(0, 0, At, B0); PG8_BAR; PG8_SCHED;
            PG8_LDB(B1, 0, 1); PG8_STAGE(PG8_SB(0, 0), b2, voffB);
            PG8_BAR; PG8_WAIT_L(0); PG8_MMA(0, 1, At, B1); PG8_BAR;
            PG8_LDA(At, 0, 1); PG8_STAGE(PG8_SA(0, 0), a2, voffA);
            PG8_BAR; PG8_WAIT_L(0); PG8_MMA(1, 0, At, B0); PG8_BAR; PG8_SCHED;
            PG8_STAGE(PG8_SB(0, 1), b2 + hstep, voffB);
            PG8_WAIT_V(6); PG8_BAR; PG8_MMA(1, 1, At, B1); PG8_BAR;
            PG8_LDB(B0, 1, 0); PG8_SCHED; PG8_LDA(At, 1, 0); PG8_STAGE(PG8_SA(0, 1), a2 + hstep, voffA);
            PG8_WAIT_L(8); PG8_BAR; PG8_WAIT_L(0); PG8_MMA(0, 0, At, B0); PG8_BAR; PG8_SCHED;
            PG8_LDB(B1, 1, 1); PG8_STAGE(PG8_SB(1, 0), b3, voffB);
            PG8_BAR; PG8_WAIT_L(0); PG8_MMA(0, 1, At, B1); PG8_BAR;
            PG8_LDA(At, 1, 1); PG8_STAGE(PG8_SA(1, 0), a3, voffA);
            PG8_BAR; PG8_WAIT_L(0); PG8_MMA(1, 0, At, B0); PG8_BAR; PG8_SCHED;
            PG8_STAGE(PG8_SB(1, 1), b3 + hstep, voffB);
            PG8_WAIT_V(6); PG8_BAR; PG8_MMA(1, 1, At, B1); PG8_BAR;
            }
        }
        if constexpr (ALIGN_EPI) { if (wr == 0) PG8_BAR; }
        if constexpr (!Epi::AFTER_DRAIN) { E(acc, cur, wr, wc, fr, fq); S.done(cur); }
        if (!has_next) break;
#pragma unroll
        for (int a = 0; a < 2; ++a)
#pragma unroll
            for (int b = 0; b < 2; ++b)
#pragma unroll
                for (int m = 0; m < 4; ++m)
#pragma unroll
                    for (int n = 0; n < 2; ++n) acc[a][b][m][n] = (f32x4){0.f, 0.f, 0.f, 0.f};
        cur = nxt; cA = nA; cB = nB; ++ui;
        if constexpr (ALIGN_EPI) { if (wr == 1) PG8_BAR; }
    }
    PG8_WAIT_V(0);
    if constexpr (!ALIGN_EPI) { if (wr == 0) PG8_BAR; }
    PG8_BAR;
    if constexpr (Epi::AFTER_DRAIN) { E.fused(acc, cur, wr, wc, fr, fq, lds, wid, lane); S.done(cur); }
#undef PG8_SA
#undef PG8_SB
#undef PG8_STAGE
#undef PG8_LDA
#undef PG8_LDB
#undef PG8_MMA
#undef PG8_WAIT_V
#undef PG8_WAIT_L
#undef PG8_BAR
#undef PG8_SCHED
}
}

#ifndef PG8_SP2
#define PG8_SP2 true
#endif
#ifndef PG8_ALIGN
#define PG8_ALIGN true
#endif

namespace mk {
using pg8::f32x4; using pg8::bf16x8; using pg8::u32x4; using pg8::Unit; using pg8::Gemm; using pg8::bf16_t; using pg8::cvt_pk_bf16; using pg8::perm32;
typedef unsigned u32x2 __attribute__((ext_vector_type(2)));
constexpr int BM = 256, HALF = 128;

__device__ __forceinline__ float row_rstd(const float* RS, int row) {
    float ss;
    if (row < MP) { const f32x4 p = *(const f32x4*)(RS + (size_t)row * 4); ss = (p[0] + p[1]) + (p[2] + p[3]); }
    else { const f32x4* q = (const f32x4*)(RS + (size_t)MP * 4 + (size_t)(row - MP) * 16); const f32x4 a = q[0], b = q[1], c = q[2], d = q[3];
           ss = (((a[0] + a[1]) + (a[2] + a[3])) + ((b[0] + b[1]) + (b[2] + b[3]))) + (((c[0] + c[1]) + (c[2] + c[3])) + ((d[0] + d[1]) + (d[2] + d[3]))); }
    return rsqrtf(ss * (1.0f / D) + NORM_EPS);
}
__device__ __forceinline__ void unit_rstd(const float* RS, int row0, float (&rs)[2][4]) {
    if (row0 < MP) {
        f32x4 p[2][4];
#pragma unroll
        for (int ai = 0; ai < 2; ++ai)
#pragma unroll
            for (int m = 0; m < 4; ++m) p[ai][m] = *(const f32x4*)(RS + (size_t)(row0 + ai * HALF + m * 16) * 4);
#pragma unroll
        for (int ai = 0; ai < 2; ++ai)
#pragma unroll
            for (int m = 0; m < 4; ++m) rs[ai][m] = rsqrtf(((p[ai][m][0] + p[ai][m][1]) + (p[ai][m][2] + p[ai][m][3])) * (1.0f / D) + NORM_EPS);
    } else {
#pragma unroll
        for (int ai = 0; ai < 2; ++ai)
#pragma unroll
            for (int m = 0; m < 4; ++m) rs[ai][m] = row_rstd(RS, row0 + ai * HALF + m * 16);
    }
}
__device__ __forceinline__ float silu_mul(float g, float u) {
    const float e = __builtin_amdgcn_exp2f(-g * LOG2E);
    return g * u * __builtin_amdgcn_rcpf(1.0f + e);
}
__device__ __forceinline__ float log_sigmoid(float x) { return fminf(x, 0.f) - log1pf(__expf(-fabsf(x))); }

struct RoundOrder : pg8::StaticOrder {
    int rnd;
    __device__ __forceinline__ bool next(int i, Unit& u) const { if (i > 0) return false; return pg8::StaticOrder::next(rnd, u); }
};

struct EpiSwiglu {
    static constexpr bool PERM = true, AFTER_DRAIN = false;
    bf16_t* Hout; const float* RS;
    __device__ __forceinline__ void operator()(const f32x4 (&acc)[2][2][4][2], const Unit& u, int wr, int wc, int fr, int fq) const {
        const int row0 = u.pm * BM + wr * 64 + fr, col0 = u.pn * HALF + wc * 32 + 8 * fq;
        float rs[2][4]; unit_rstd(RS, row0, rs);
#pragma unroll
        for (int ai = 0; ai < 2; ++ai)
#pragma unroll
            for (int m = 0; m < 4; ++m) {
                const int row = row0 + ai * HALF + m * 16; const float r = rs[ai][m];
                const f32x4 g0 = acc[ai][0][m][0] * r, g1 = acc[ai][0][m][1] * r, u0 = acc[ai][1][m][0] * r, u1 = acc[ai][1][m][1] * r;
                u32x4 w;
                w.x = cvt_pk_bf16(silu_mul(g0[0], u0[0]), silu_mul(g0[1], u0[1])); w.y = cvt_pk_bf16(silu_mul(g0[2], u0[2]), silu_mul(g0[3], u0[3]));
                w.z = cvt_pk_bf16(silu_mul(g1[0], u1[0]), silu_mul(g1[1], u1[1])); w.w = cvt_pk_bf16(silu_mul(g1[2], u1[2]), silu_mul(g1[3], u1[3]));
                *(u32x4*)(Hout + (size_t)row * FF + col0) = w;
            }
    }
};

template <bool BASE_F32  , bool OUT_F32  > struct EpiRes {
    static constexpr bool PERM = false, AFTER_DRAIN = true;
    const float* base_p; const float* base_s; float* X; bf16_t* XB; float* RS; float scale;
    __device__ __forceinline__ void fused(f32x4 (&acc)[2][2][4][2], const Unit& u, int wr, int wc, int fr, int fq, PG8_LAS unsigned char* lds, int wid, int lane) const {
        PG8_LAS float* P = (PG8_LAS float*)lds;
        const int col0 = u.pn * BM + wc * 32 + 4 * fq;
#pragma unroll
        for (int ai = 0; ai < 2; ++ai)
#pragma unroll
            for (int m = 0; m < 4; ++m) {
                const int rl = ai * HALF + wr * 64 + m * 16 + fr, row = u.pm * BM + rl;
                const float* bp = row < MP ? base_p + (size_t)row * D : base_s + (size_t)(row - MP) * D;
                float ss = 0.f;
#pragma unroll
                for (int bj = 0; bj < 2; ++bj)
#pragma unroll
                    for (int n = 0; n < 2; ++n) {
                        const int c = col0 + bj * HALF + n * 16;
                        f32x4 b;
                        if (BASE_F32) b = *(const f32x4*)(bp + c);
                        else { const u32x2 wb = *(const u32x2*)(XB + (size_t)row * D + c); b = (f32x4){__builtin_bit_cast(float, wb.x << 16), __builtin_bit_cast(float, wb.x & 0xffff0000u), __builtin_bit_cast(float, wb.y << 16), __builtin_bit_cast(float, wb.y & 0xffff0000u)}; }
                        const f32x4 v = b + acc[ai][bj][m][n] * scale;
                        if (OUT_F32) *(f32x4*)(X + (size_t)row * D + c) = v;
                        else { u32x2 w; w.x = cvt_pk_bf16(v[0], v[1]); w.y = cvt_pk_bf16(v[2], v[3]); *(u32x2*)(XB + (size_t)row * D + c) = w; }
                        ss += (v[0] * v[0] + v[1] * v[1]) + (v[2] * v[2] + v[3] * v[3]);
                    }
                ss += __shfl_xor(ss, 16); ss += __shfl_xor(ss, 32);
                if (fq == 0) P[rl * 4 + wc] = ss;
                if (m & 1) asm volatile("" ::: "memory");
            }
        asm volatile("s_waitcnt lgkmcnt(0)" ::: "memory"); __builtin_amdgcn_s_barrier(); asm volatile("" ::: "memory");
        const int t = wid * 64 + lane;
        if (!OUT_F32 && t < 256) { const f32x4 p = *(const PG8_LAS f32x4*)(P + t * 4); RS[(size_t)(u.pm * BM + t) * 4 + u.pn] = (p[0] + p[1]) + (p[2] + p[3]); }
        asm volatile("s_waitcnt lgkmcnt(0)" ::: "memory"); __builtin_amdgcn_s_barrier(); asm volatile("" ::: "memory");
    }
};

struct EpiConvIn {
    static constexpr bool PERM = true, AFTER_DRAIN = false;
    bf16_t* G; bf16_t* U; const float* RS; float* cs_p; float* cs_s;
    __device__ __forceinline__ void operator()(const f32x4 (&acc)[2][2][4][2], const Unit& u, int wr, int wc, int fr, int fq) const {
        const int row0 = u.pm * BM + wr * 64 + fr;
        float rs[2][4]; unit_rstd(RS, row0, rs);
        if (u.pn < 4) {
            const int col0 = u.pn * BM + wc * 32 + 8 * fq;
#pragma unroll
            for (int ai = 0; ai < 2; ++ai)
#pragma unroll
                for (int m = 0; m < 4; ++m) {
                    const int row = row0 + ai * HALF + m * 16; const float r = rs[ai][m];
#pragma unroll
                    for (int bj = 0; bj < 2; ++bj) { const f32x4 v0 = acc[ai][bj][m][0] * r, v1 = acc[ai][bj][m][1] * r;
                        u32x4 w; w.x = cvt_pk_bf16(v0[0], v0[1]); w.y = cvt_pk_bf16(v0[2], v0[3]); w.z = cvt_pk_bf16(v1[0], v1[1]); w.w = cvt_pk_bf16(v1[2], v1[3]);
                        *(u32x4*)(G + (size_t)row * D + col0 + bj * HALF) = w; }
                }
        } else {
            const int col0 = (u.pn - 4) * HALF + wc * 32 + 8 * fq;
#pragma unroll
            for (int ai = 0; ai < 2; ++ai)
#pragma unroll
                for (int m = 0; m < 4; ++m) {
                    const int row = row0 + ai * HALF + m * 16; const float r = rs[ai][m], r2 = r * r;
                    const f32x4 v0 = acc[ai][0][m][0] * acc[ai][1][m][0] * r2, v1 = acc[ai][0][m][1] * acc[ai][1][m][1] * r2;
                    u32x4 w; w.x = cvt_pk_bf16(v0[0], v0[1]); w.y = cvt_pk_bf16(v0[2], v0[3]); w.z = cvt_pk_bf16(v1[0], v1[1]); w.w = cvt_pk_bf16(v1[2], v1[3]);
                    *(u32x4*)(U + (size_t)row * D + col0) = w;
                    float* cs = nullptr;
                    if (row < MP) { const int t = row & (SEQ - 1); if (t >= SEQ - 2) cs = cs_p + ((size_t)(row >> 11) * 2 + (t - (SEQ - 2))) * D; }
                    else { const int rr = row - MP, t = rr & (DSEQ - 1); if (t >= DSEQ - 2) cs = cs_s + ((size_t)(rr >> 6) * 2 + (t - (DSEQ - 2))) * D; }
                    if (cs) { *(f32x4*)(cs + col0) = v0; *(f32x4*)(cs + col0 + 4) = v1; }
                }
        }
    }
};

struct EpiAttnIn {
    static constexpr bool PERM = true, AFTER_DRAIN = false;
    bf16_t *Qb, *Kb, *Vb; const float* RS; const float *gq, *gk, *bfg; float *k_p, *k_s, *v_p, *v_s, *lf_p, *lf_s;
    __device__ __forceinline__ void operator()(const f32x4 (&acc)[2][2][4][2], const Unit& u, int wr, int wc, int fr, int fq) const {
        const int row0 = u.pm * BM + wr * 64 + fr, pn = u.pn;
        float rs[2][4]; unit_rstd(RS, row0, rs);
        if (pn < 8) {
            const bool isq = pn < 4; const float* gg = isq ? gq : gk;
            f32x4 gv[2][2];
#pragma unroll
            for (int bj = 0; bj < 2; ++bj)
#pragma unroll
                for (int n = 0; n < 2; ++n) gv[bj][n] = *(const f32x4*)(gg + 32 * bj + 8 * fq + 4 * n);
            const int hcol = ((pn & 3) * 4 + wc) * HD + 8 * fq;
#pragma unroll
            for (int ai = 0; ai < 2; ++ai)
#pragma unroll
                for (int m = 0; m < 4; ++m) {
                    const int row = row0 + ai * HALF + m * 16; const float r = rs[ai][m];
                    float ss = 0.f;
#pragma unroll
                    for (int bj = 0; bj < 2; ++bj)
#pragma unroll
                        for (int n = 0; n < 2; ++n) { const f32x4 a = acc[ai][bj][m][n]; ss += (a[0] * a[0] + a[1] * a[1]) + (a[2] * a[2] + a[3] * a[3]); }
                    ss += __shfl_xor(ss, 16); ss += __shfl_xor(ss, 32);
                    const float f = r * rsqrtf(r * r * ss * (1.0f / HD) + NORM_EPS);
                    float* ko = nullptr; if (!isq) ko = (row < MP ? k_p + (size_t)row * D : k_s + (size_t)(row - MP) * D) + hcol;
#pragma unroll
                    for (int bj = 0; bj < 2; ++bj) {
                        const f32x4 o0 = acc[ai][bj][m][0] * f * gv[bj][0], o1 = acc[ai][bj][m][1] * f * gv[bj][1];
                        if (isq) { const f32x4 s0 = o0 * QSCALE, s1 = o1 * QSCALE;
                            u32x4 w; w.x = cvt_pk_bf16(s0[0], s0[1]); w.y = cvt_pk_bf16(s0[2], s0[3]); w.z = cvt_pk_bf16(s1[0], s1[1]); w.w = cvt_pk_bf16(s1[2], s1[3]);
                            *(u32x4*)(Qb + (size_t)row * D + hcol + 32 * bj) = w; }
                        else { u32x4 w; w.x = cvt_pk_bf16(o0[0], o0[1]); w.y = cvt_pk_bf16(o0[2], o0[3]); w.z = cvt_pk_bf16(o1[0], o1[1]); w.w = cvt_pk_bf16(o1[2], o1[3]);
                            *(u32x4*)(Kb + (size_t)row * D + hcol + 32 * bj) = w;
                            *(f32x4*)(ko + 32 * bj) = o0; *(f32x4*)(ko + 32 * bj + 4) = o1; }
                    }
                }
        } else if (pn < 12) {
            const int col0 = (pn - 8) * BM + wc * 32 + 8 * fq;
#pragma unroll
            for (int ai = 0; ai < 2; ++ai)
#pragma unroll
                for (int m = 0; m < 4; ++m) {
                    const int row = row0 + ai * HALF + m * 16; const float r = rs[ai][m];
                    float* vo = (row < MP ? v_p + (size_t)row * D : v_s + (size_t)(row - MP) * D) + col0;
#pragma unroll
                    for (int bj = 0; bj < 2; ++bj) { const f32x4 o0 = acc[ai][bj][m][0] * r, o1 = acc[ai][bj][m][1] * r;
                        u32x4 w; w.x = cvt_pk_bf16(o0[0], o0[1]); w.y = cvt_pk_bf16(o0[2], o0[3]); w.z = cvt_pk_bf16(o1[0], o1[1]); w.w = cvt_pk_bf16(o1[2], o1[3]);
                        *(u32x4*)(Vb + (size_t)row * D + col0 + bj * HALF) = w;
                        *(f32x4*)(vo + bj * HALF) = o0; *(f32x4*)(vo + bj * HALF + 4) = o1; }
                }
        } else {
            if (wc == 0 && fq < 2) {
                const f32x4 b0 = *(const f32x4*)(bfg + 8 * fq), b1 = *(const f32x4*)(bfg + 8 * fq + 4);
#pragma unroll
                for (int ai = 0; ai < 2; ++ai)
#pragma unroll
                    for (int m = 0; m < 4; ++m) {
                        const int row = row0 + ai * HALF + m * 16; const float r = rs[ai][m];
                        float* lo = (row < MP ? lf_p + (size_t)row * NH : lf_s + (size_t)(row - MP) * NH) + 8 * fq;
                        const f32x4 a0 = acc[ai][0][m][0] * r + b0, a1 = acc[ai][0][m][1] * r + b1;
                        f32x4 l0, l1;
#pragma unroll
                        for (int j = 0; j < 4; ++j) { l0[j] = log_sigmoid(a0[j]); l1[j] = log_sigmoid(a1[j]); }
                        *(f32x4*)lo = l0; *(f32x4*)(lo + 4) = l1;
                    }
            }
        }
    }
};

template <class Epi, class Sched>
__device__ __forceinline__ void gemm_phase_simple(PG8_LAS unsigned char* lds, const Gemm g, const Sched& S, const Epi& E) {
    int tid = threadIdx.x; asm volatile("" : "+v"(tid));
    const int wid = __builtin_amdgcn_readfirstlane(tid >> 6), lane = tid & 63, wr = wid >> 2, wc = wid & 3, fr = lane & 15, fq = lane >> 4;
    const int K = g.K;
    Unit cur;
    for (int ui = 0; S.next(ui, cur); ++ui) {
        f32x4 acc[2][2][4][2];
#pragma unroll
        for (int a = 0; a < 2; ++a)
#pragma unroll
            for (int b = 0; b < 2; ++b)
#pragma unroll
                for (int m = 0; m < 4; ++m)
#pragma unroll
                    for (int n = 0; n < 2; ++n) acc[a][b][m][n] = (f32x4){0.f, 0.f, 0.f, 0.f};
        const bf16_t* Ab = g.A + (size_t)(cur.pm * BM + wr * 64 + fr) * K + fq * 8;
        const bf16_t* Bb = g.Bt + (size_t)(cur.pn * BM + wc * 32) * K + fq * 8;
        const int br0 = Epi::PERM ? perm32(fr) : fr, br1 = Epi::PERM ? perm32(16 + fr) : 16 + fr;
        for (int kt = 0; kt < K; kt += 32) {
            bf16x8 a[2][4], b[2][2];
#pragma unroll
            for (int ai = 0; ai < 2; ++ai)
#pragma unroll
                for (int m = 0; m < 4; ++m) a[ai][m] = *(const bf16x8*)(Ab + (size_t)(ai * HALF + m * 16) * K + kt);
#pragma unroll
            for (int bj = 0; bj < 2; ++bj) { b[bj][0] = *(const bf16x8*)(Bb + (size_t)(bj * HALF + br0) * K + kt); b[bj][1] = *(const bf16x8*)(Bb + (size_t)(bj * HALF + br1) * K + kt); }
#pragma unroll
            for (int ai = 0; ai < 2; ++ai)
#pragma unroll
                for (int bj = 0; bj < 2; ++bj)
#pragma unroll
                    for (int m = 0; m < 4; ++m)
#pragma unroll
                        for (int n = 0; n < 2; ++n) acc[ai][bj][m][n] = __builtin_amdgcn_mfma_f32_16x16x32_bf16(b[bj][n], a[ai][m], acc[ai][bj][m][n], 0, 0, 0);
        }
        if constexpr (Epi::AFTER_DRAIN) { __syncthreads(); E.fused(acc, cur, wr, wc, fr, fq, lds, wid, lane); __syncthreads(); }
        else E(acc, cur, wr, wc, fr, fq);
    }
}
}
#include <hip/hip_bf16.h>
#include <cmath>
namespace attn_body {
using bf16=__hip_bfloat16;
using bf16x8=__attribute__((ext_vector_type(8)))short;
using s16x4=__attribute__((ext_vector_type(4)))short;
using f32x16=__attribute__((ext_vector_type(16)))float;
using u32x4=__attribute__((ext_vector_type(4)))unsigned;
constexpr int BATCH=8,NHEAD=16,SEQ=2048,D=64,DM=NHEAD*D;
constexpr int NW=8,QBLK=32,QB=QBLK*NW,KVBLK=64,NQB=SEQ/QB;
constexpr int ATTN_PITCH=DM, ATTN_UNIT_ROWS=QB;
__device__ __forceinline__ int crow(int r,int hi){return (r&3)+8*(r>>2)+4*hi;}
#define SBAR() __builtin_amdgcn_sched_barrier(0)
__device__ __forceinline__ void cmask(f32x16&p0,f32x16&p1,int jb,int qrel,int hi){
  const float NEG=-INFINITY; int kb=64*jb+4*hi;
  #pragma unroll
  for(int r=0;r<16;++r){int kv=kb+(r&3)+8*(r>>2); if(kv>qrel)p0[r]=NEG; if(kv+32>qrel)p1[r]=NEG;}
}

constexpr int NSLOT=3, SLOTB=8192;
constexpr int LDS_K=0, LDS_V=NSLOT*SLOTB, LDS_WS=2*NSLOT*SLOTB, LDS_OST=LDS_WS+NW*64*4, LDS_BYTES=LDS_OST+NW*4096;
constexpr float C2=0.125f*1.4426950408889634f;
__device__ __forceinline__ void glds16(const void*gsrc,unsigned lds_dst){unsigned keep;
  asm volatile("s_mov_b32 %0, m0\n\ts_mov_b32 m0, %2\n\ts_nop 0\n\tglobal_load_lds_dwordx4 %1, off\n\ts_mov_b32 m0, %0":"=&s"(keep):"v"(gsrc),"s"(lds_dst):"memory");}
__device__ __forceinline__ float max3f(float a,float b,float c){float r;asm("v_max3_f32 %0, %1, %2, %3":"=v"(r):"v"(a),"v"(b),"v"(c));return r;}
__device__ __forceinline__ float max2f(float a,float b){float r;asm("v_max_f32_e32 %0, %1, %2":"=v"(r):"v"(a),"v"(b));return r;}
__device__ __forceinline__ float fadd_s(float a,float b){float r;asm("v_add_f32_e32 %0, %1, %2":"=v"(r):"v"(a),"v"(b));return r;}
__device__ __forceinline__ float fsub_s(float a,float b){float r;asm("v_sub_f32_e32 %0, %1, %2":"=v"(r):"v"(a),"v"(b));return r;}
typedef float f32x2_t __attribute__((ext_vector_type(2))); typedef __bf16 bf16x2_t __attribute__((ext_vector_type(2)));
__device__ __forceinline__ unsigned cvtpk_s(float lo,float hi){f32x2_t v={lo,hi};bf16x2_t b=__builtin_convertvector(v,bf16x2_t);return __builtin_bit_cast(unsigned,b);}
#define WAIT_BAR(N) asm volatile("s_waitcnt vmcnt(" #N ") lgkmcnt(0)\n\ts_barrier":::"memory")

__device__ __forceinline__ void qkt(f32x16&p0,f32x16&p1,const char*Kslot,const bf16x8*qr,int r32,int hi){
  const char*kb=Kslot+hi*1024+r32*16;
  #pragma unroll
  for(int d0=0;d0<4;++d0){
    const bf16x8 b0=*reinterpret_cast<const bf16x8*>(kb+d0*2048);
    const bf16x8 b1=*reinterpret_cast<const bf16x8*>(kb+d0*2048+512);
    if(d0==0){p0=__builtin_amdgcn_mfma_f32_32x32x16_bf16(b0,qr[0],f32x16{},0,0,0);p1=__builtin_amdgcn_mfma_f32_32x32x16_bf16(b1,qr[0],f32x16{},0,0,0);}
    else{p0=__builtin_amdgcn_mfma_f32_32x32x16_bf16(b0,qr[d0],p0,0,0,0);p1=__builtin_amdgcn_mfma_f32_32x32x16_bf16(b1,qr[d0],p1,0,0,0);}}
}
typedef __attribute__((address_space(3))) const char* lds_cptr;
typedef short v4i16_t __attribute__((ext_vector_type(4)));
__device__ __forceinline__ void kload8(bf16x8*kf,lds_cptr kp){
  kf[0]=*(const __attribute__((address_space(3))) bf16x8*)(kp);      kf[1]=*(const __attribute__((address_space(3))) bf16x8*)(kp+512);
  kf[2]=*(const __attribute__((address_space(3))) bf16x8*)(kp+2048); kf[3]=*(const __attribute__((address_space(3))) bf16x8*)(kp+2560);
  kf[4]=*(const __attribute__((address_space(3))) bf16x8*)(kp+4096); kf[5]=*(const __attribute__((address_space(3))) bf16x8*)(kp+4608);
  kf[6]=*(const __attribute__((address_space(3))) bf16x8*)(kp+6144); kf[7]=*(const __attribute__((address_space(3))) bf16x8*)(kp+6656);
}
__device__ __forceinline__ void kload2(bf16x8*kf,lds_cptr kp,int j){ kf[2*j]=*(const __attribute__((address_space(3))) bf16x8*)(kp+j*2048); kf[2*j+1]=*(const __attribute__((address_space(3))) bf16x8*)(kp+j*2048+512); }
__device__ __forceinline__ s16x4 vtr(lds_cptr p){ return __builtin_bit_cast(s16x4,__builtin_amdgcn_ds_read_tr16_b64_v4i16((__attribute__((address_space(3))) v4i16_t*)p)); }
__device__ __forceinline__ float rowmax(const f32x16&p0,const f32x16&p1){
  float a=max3f(p0[0],p0[1],p1[0]),b=max3f(p0[2],p0[3],p1[1]);a=max3f(a,p1[2],p1[3]);
  #pragma unroll
  for(int r=4;r<16;r+=4){a=max3f(a,p0[r],p0[r+1]);b=max3f(b,p0[r+2],p0[r+3]);a=max3f(a,p1[r],p1[r+1]);b=max3f(b,p1[r+2],p1[r+3]);}
  const float m=max2f(a,b);
  auto rr=__builtin_amdgcn_permlane32_swap(__float_as_uint(m),__float_as_uint(m),false,false);
  return max2f(__uint_as_float(rr[0]),__uint_as_float(rr[1]));
}
__device__ __forceinline__ void pv(f32x16*o,int vb,bf16x8 pa0,bf16x8 pa1,bf16x8 pa2,bf16x8 pa3){
  #pragma unroll
  for(int d0=0;d0<2;++d0){s16x4 lo[4],hi[4];
    #pragma unroll
    for(int ks=0;ks<4;++ks){
      asm volatile("ds_read_b64_tr_b16 %0,%1 offset:%c2":"=&v"(lo[ks]):"v"(vb),"i"(d0*4096+ks*1024):"memory");
      asm volatile("ds_read_b64_tr_b16 %0,%1 offset:%c2":"=&v"(hi[ks]):"v"(vb),"i"(d0*4096+ks*1024+512):"memory");}
    asm volatile("s_waitcnt lgkmcnt(0)":::"memory");SBAR();
    #define PK(k) (bf16x8){lo[k][0],lo[k][1],lo[k][2],lo[k][3],hi[k][0],hi[k][1],hi[k][2],hi[k][3]}
    o[d0]=__builtin_amdgcn_mfma_f32_32x32x16_bf16(pa0,PK(0),o[d0],0,0,0);
    o[d0]=__builtin_amdgcn_mfma_f32_32x32x16_bf16(pa1,PK(1),o[d0],0,0,0);
    o[d0]=__builtin_amdgcn_mfma_f32_32x32x16_bf16(pa2,PK(2),o[d0],0,0,0);
    o[d0]=__builtin_amdgcn_mfma_f32_32x32x16_bf16(pa3,PK(3),o[d0],0,0,0);
    #undef PK
  }
}

#ifndef ATTN_STORE16
#define ATTN_STORE16(p,v) (*(u32x4*)(p)=(v))
#endif
template<int THRL> __device__ __forceinline__ void attn_unit(int b,int h,int qb,const bf16*Q,const bf16*__restrict__ K,const bf16*__restrict__ V,bf16*O,char*shm,lds_cptr btab,unsigned mhalf_bits){
  int tid=threadIdx.x; asm volatile("":"+v"(tid)); const int lane=tid&63,r32=lane&31,hi=lane>>5; const int wid=__builtin_amdgcn_readfirstlane(tid>>6);
  const long rowbase=(long)b*SEQ; const int q0=qb*QB;
  const bf16*Qw=Q+(rowbase+q0+wid*QBLK)*DM+h*D;
  const bf16*Kh=K+rowbase*DM+h*D,*Vh=V+rowbase*DM+h*D;
  const unsigned lds0=(unsigned)(uintptr_t)shm;
  float*wsf=(float*)(shm+LDS_WS)+wid*64;
  const bf16*ksrc=Kh+(long)lane*DM+wid*8;
  const bf16*vsrc=Vh+(long)(16*(wid&3)+(lane>>2))*DM+(wid>>2)*32+(lane&3)*8;
  const unsigned kdst=lds0+LDS_K+wid*1024, vdst=lds0+LDS_V+wid*1024;
  #define DMA_K(t,slot) glds16(ksrc+(long)(t)*KVBLK*DM,(unsigned)__builtin_amdgcn_readfirstlane(kdst+(slot)))
  #define DMA_V(t,slot) glds16(vsrc+(long)(t)*KVBLK*DM,(unsigned)__builtin_amdgcn_readfirstlane(vdst+(slot)))
  const int vb0=(int)(lds0+LDS_V)+((lane>>4)&1)*32+(lane&3)*8+(4*hi+((lane&15)>>2))*64;
  const char*Kbase=shm+LDS_K; bf16x8 kf[8];
  const lds_cptr shm3=(lds_cptr)shm; const lds_cptr kp0=shm3+LDS_K+hi*1024+r32*16; const lds_cptr vp0=shm3+LDS_V+((lane>>4)&1)*32+(lane&3)*8+(4*hi+((lane&15)>>2))*64;
  const int NT=(q0+QB)/KVBLK;
  DMA_K(0,0);DMA_V(0,0);DMA_K(1,SLOTB);
  bf16x8 qr[4];
  #pragma unroll
  for(int d0=0;d0<4;++d0)qr[d0]=*reinterpret_cast<const bf16x8*>(&Qw[(long)r32*DM+d0*16+hi*8]);
  float l_reg=0.f;f32x16 o[2];o[0]=f32x16{};o[1]=f32x16{};
  const int qrel=wid*QBLK+r32;
  const lds_cptr bx0=btab+r32*16;
  #define KXLD(t_,kxa,kxb) do{ const lds_cptr p_=bx0+(t_)*1024; kxa=*(const __attribute__((address_space(3))) bf16x8*)(p_); kxb=*(const __attribute__((address_space(3))) bf16x8*)(p_+512); }while(0)
  unsigned qx1,qx2; { const u32x4 e_=*(const __attribute__((address_space(3))) u32x4*)(btab+(q0+qrel)*16); qx1=0x3F80u|((e_[0]<<16)^0x80000000u); qx2=((e_[0]>>16)^0x8000u)|((e_[1]<<16)^0x80000000u); }
  #define QX() __builtin_bit_cast(bf16x8,(u32x4){0x3F803F80u,qx1,qx2,mhalf_bits})
  #define CMASK(P0,P1,t) do{int jb_=(t)-(NT-4); if(jb_>=0)cmask(P0,P1,jb_,qrel,hi);}while(0)
  #define START(P0,P1) do{ _Pragma("unroll") for(int r=0;r<16;++r)P0[r]=__builtin_amdgcn_exp2f(P0[r]); }while(0)
  #define RESC() do{}while(0)
  f32x16 pA0,pA1,pB0,pB1;
  int sl_prev=0,sl_cur=0,sl_next=SLOTB;
  #define ROT() do{sl_prev=sl_cur;sl_cur=sl_next;sl_next=(sl_next==(NSLOT-1)*SLOTB)?0:sl_next+SLOTB;}while(0)
  DMA_K(2,2*SLOTB);
  WAIT_BAR(3);
  qkt(pA0,pA1,Kbase,qr,r32,hi);
  { bf16x8 kxa,kxb; KXLD(0,kxa,kxb); pA0=__builtin_amdgcn_mfma_f32_32x32x16_bf16(kxa,QX(),pA0,0,0,0); pA1=__builtin_amdgcn_mfma_f32_32x32x16_bf16(kxb,QX(),pA1,0,0,0); }
  CMASK(pA0,pA1,0);
  START(pA0,pA1);
  _Pragma("unroll") for(int r=0;r<16;++r)pA1[r]=__builtin_amdgcn_exp2f(pA1[r]);
  WAIT_BAR(0);
  DMA_K(3,0);DMA_V(1,SLOTB);
  ROT();
  kload8(kf,kp0+sl_cur);
  WAIT_BAR(2);
  s16x4 vlo[8],vhi[8]; u32x4 pw0,pw1,pw2,pw3;
  #define PKW(P,B) cvtpk_s(P[B],P[B+1])
  #define PAF(k) __builtin_bit_cast(bf16x8,pw##k)
  #define VFR(i) (bf16x8){vlo[i][0],vlo[i][1],vlo[i][2],vlo[i][3],vhi[i][0],vhi[i][1],vhi[i][2],vhi[i][3]}
  #define PIN(x) asm volatile("":"+v"(x))
  #define MX3(a,b,c) __builtin_fmaxf(__builtin_fmaxf((a),(b)),(c))
  #define GAPA(MF,A0,A1,A2,A3,W0,W1,PW) do{ MF; sacc+=A0; sacc+=A1; sacc+=A2; sacc+=A3; PIN(sacc); W0; W1; PIN(PW); SBAR(); }while(0)
  #define EX(v) __builtin_amdgcn_exp2f(v)
  #define GAPB(MF,X,B) do{ MF; X[B]=EX(X[B]); X[B+1]=EX(X[B+1]); X[B+2]=EX(X[B+2]); X[B+3]=EX(X[B+3]); PIN(X); SBAR(); }while(0)
  #define VRD(i) do{ vlo[i]=vtr(vp_+(((i)>>2)*4096+((i)&3)*1024)); vhi[i]=vtr(vp_+(((i)>>2)*4096+((i)&3)*1024+512)); }while(0)
  #define KRD(G,j) do{ if(G){ kload2(kf,kp0+sl_next,j); SBAR(); } }while(0)
  #define STEP(C0,C1,P0,P1,t,GK,GV,GL) do{ SBAR(); \
    const lds_cptr vp_=vp0+sl_prev; \
    bf16x8 kxa_,kxb_; \
    VRD(0); SBAR(); float sacc=(P0[0]+P0[1]); \
    GAPA(C0=__builtin_amdgcn_mfma_f32_32x32x16_bf16(kf[0],qr[0],f32x16{},0,0,0), P0[2],P0[3],P0[4],P0[5],     pw0[0]=PKW(P0,0), pw0[1]=PKW(P0,2), pw0); \
    VRD(4); SBAR(); GAPA(C1=__builtin_amdgcn_mfma_f32_32x32x16_bf16(kf[1],qr[0],f32x16{},0,0,0), P0[6],P0[7],P0[8],P0[9],     pw0[2]=PKW(P0,4), pw0[3]=PKW(P0,6), pw0); \
    VRD(1); SBAR(); GAPA(C0=__builtin_amdgcn_mfma_f32_32x32x16_bf16(kf[2],qr[1],C0,0,0,0),   P0[10],P0[11],P0[12],P0[13], pw1[0]=PKW(P0,8), pw1[1]=PKW(P0,10), pw1); \
    VRD(5); SBAR(); GAPA(C1=__builtin_amdgcn_mfma_f32_32x32x16_bf16(kf[3],qr[1],C1,0,0,0),   P0[14],P0[15],P1[0],P1[1],   pw1[2]=PKW(P0,12),pw1[3]=PKW(P0,14), pw1); \
    KXLD(t,kxa_,kxb_); VRD(2); SBAR(); GAPA(C0=__builtin_amdgcn_mfma_f32_32x32x16_bf16(kf[4],qr[2],C0,0,0,0),   P1[2],P1[3],P1[4],P1[5],     pw2[0]=PKW(P1,0), pw2[1]=PKW(P1,2), pw2); \
    VRD(6); SBAR(); GAPA(C1=__builtin_amdgcn_mfma_f32_32x32x16_bf16(kf[5],qr[2],C1,0,0,0),   P1[6],P1[7],P1[8],P1[9],     pw2[2]=PKW(P1,4), pw2[3]=PKW(P1,6), pw2); \
    VRD(3); SBAR(); GAPA(C0=__builtin_amdgcn_mfma_f32_32x32x16_bf16(kf[6],qr[3],C0,0,0,0),   P1[10],P1[11],P1[12],P1[13], pw3[0]=PKW(P1,8), pw3[1]=PKW(P1,10), pw3); \
    VRD(7); SBAR(); GAPA(C1=__builtin_amdgcn_mfma_f32_32x32x16_bf16(kf[7],qr[3],C1,0,0,0),   P1[14],P1[15],0.f,0.f,       pw3[2]=PKW(P1,12),pw3[3]=PKW(P1,14), pw3); \
    C0=__builtin_amdgcn_mfma_f32_32x32x16_bf16(kxa_,QX(),C0,0,0,0); C1=__builtin_amdgcn_mfma_f32_32x32x16_bf16(kxb_,QX(),C1,0,0,0); SBAR(); \
    l_reg+=sacc; \
    if(GK){DMA_K((t)+3,sl_cur);} if(GV){DMA_V((t)+1,sl_next);} \
    CMASK(C0,C1,t); \
    SBAR(); \
    GAPB(o[0]=__builtin_amdgcn_mfma_f32_32x32x16_bf16(PAF(0),VFR(0),o[0],0,0,0), C0,0); \
    GAPB(o[1]=__builtin_amdgcn_mfma_f32_32x32x16_bf16(PAF(0),VFR(4),o[1],0,0,0), C0,4); \
    KRD(GL,0); GAPB(o[0]=__builtin_amdgcn_mfma_f32_32x32x16_bf16(PAF(1),VFR(1),o[0],0,0,0), C0,8); \
    KRD(GL,1); GAPB(o[1]=__builtin_amdgcn_mfma_f32_32x32x16_bf16(PAF(1),VFR(5),o[1],0,0,0), C0,12); \
    KRD(GL,2); GAPB(o[0]=__builtin_amdgcn_mfma_f32_32x32x16_bf16(PAF(2),VFR(2),o[0],0,0,0), C1,0); \
    KRD(GL,3); GAPB(o[1]=__builtin_amdgcn_mfma_f32_32x32x16_bf16(PAF(2),VFR(6),o[1],0,0,0), C1,4); \
    GAPB(o[0]=__builtin_amdgcn_mfma_f32_32x32x16_bf16(PAF(3),VFR(3),o[0],0,0,0), C1,8); \
    GAPB(o[1]=__builtin_amdgcn_mfma_f32_32x32x16_bf16(PAF(3),VFR(7),o[1],0,0,0), C1,12); \
    }while(0)
  int t=1;
  #undef CMASK
  #define CMASK(P0,P1,t) do{}while(0)
  for(;t+5<NT;t+=2){
    STEP(pB0,pB1,pA0,pA1,t,true,true,true);     WAIT_BAR(2); RESC(); ROT();
    STEP(pA0,pA1,pB0,pB1,t+1,true,true,true);   WAIT_BAR(2); RESC(); ROT();
  }
  #undef CMASK
  #define CMASK(P0,P1,t) do{int jb_=(t)-(NT-4); if(jb_>=0)cmask(P0,P1,jb_,qrel,hi);}while(0)
  #define ENDW(tt) do{ if((tt)+3<NT){WAIT_BAR(2);} else if((tt)+2<NT){WAIT_BAR(1);} else {WAIT_BAR(0);} }while(0)
  for(;t+1<NT;t+=2){
    STEP(pB0,pB1,pA0,pA1,t,(t+3<NT),(t+1<NT),(t+1<NT));       ENDW(t);   RESC(); ROT();
    STEP(pA0,pA1,pB0,pB1,t+1,(t+4<NT),(t+2<NT),(t+2<NT));     ENDW(t+1); RESC(); ROT();
  }
  STEP(pB0,pB1,pA0,pA1,NT-1,false,false,false); RESC();
  { float sacc=pB0[0]+pB0[1]; _Pragma("unroll") for(int r=2;r<16;++r)sacc+=pB0[r]; _Pragma("unroll") for(int r=0;r<16;++r)sacc+=pB1[r]; l_reg+=sacc;
    pw0=(u32x4){PKW(pB0,0),PKW(pB0,2),PKW(pB0,4),PKW(pB0,6)};pw1=(u32x4){PKW(pB0,8),PKW(pB0,10),PKW(pB0,12),PKW(pB0,14)};pw2=(u32x4){PKW(pB1,0),PKW(pB1,2),PKW(pB1,4),PKW(pB1,6)};pw3=(u32x4){PKW(pB1,8),PKW(pB1,10),PKW(pB1,12),PKW(pB1,14)};
    SBAR(); pv(o,vb0+sl_cur,PAF(0),PAF(1),PAF(2),PAF(3)); }
  #undef PKW
  #undef PAF
  #undef VFR
  #undef PIN
  #undef MX3
  #undef GAPA
  #undef GAPB
  #undef EX
  #undef VRD
  #undef KRD
  #undef STEP
  #undef ENDW
  {auto rr=__builtin_amdgcn_permlane32_swap(__float_as_uint(l_reg),__float_as_uint(l_reg),false,false);l_reg=__uint_as_float(rr[0])+__uint_as_float(rr[1]);}
  if(hi==0)wsf[32+r32]=l_reg;asm volatile("s_waitcnt lgkmcnt(0)":::"memory");
  float rli[16];
  #pragma unroll
  for(int r=0;r<16;++r)rli[r]=__builtin_amdgcn_rcpf(wsf[32+crow(r,hi)]);
  bf16*Ow=O+(rowbase+q0+wid*QBLK)*DM+h*D;
  { bf16*stg=(bf16*)(shm+LDS_OST)+wid*2048;
    #pragma unroll
    for(int r=0;r<16;++r){const int orow=crow(r,hi);
      #pragma unroll
      for(int d0=0;d0<2;++d0)stg[orow*64+d0*32+r32]=__float2bfloat16(o[d0][r]*rli[r]);}
    asm volatile("s_waitcnt lgkmcnt(0)":::"memory");
    #pragma unroll
    for(int i=0;i<4;++i){const int row=i*8+(lane>>3),ch=lane&7; const u32x4 v=*(const u32x4*)(stg+row*64+ch*8); ATTN_STORE16(Ow+(long)row*DM+ch*8,v);} }
  asm volatile("s_waitcnt lgkmcnt(0)\n\ts_barrier":::"memory");
  #undef DMA_K
  #undef DMA_V
  #undef CMASK
  #undef START
  #undef RESC
  #undef ROT
  #undef KXLD
  #undef QX
}
constexpr int ATTN_LDS_BYTES=LDS_BYTES;
struct AttnTensors { const bf16* Q; const bf16* K; const bf16* V; bf16* O; };
struct AttnUnit { int bh; int qb; };
struct StaticOrder {
  int vcu;
  __device__ __forceinline__ explicit StaticOrder(int v):vcu(v){}
  __device__ __forceinline__ bool next(int i,AttnUnit&u)const{ if(i>=4)return false; const int s=vcu&1; u.bh=vcu>>1; u.qb=(i==0)?7-s:(i==1)?4+s:(i==2)?3-s:s; return true; }
  __device__ __forceinline__ void a_ready(const AttnUnit&)const{}
  __device__ __forceinline__ void done(const AttnUnit&)const{}
};
template<class Sched,int THRL=8> __device__ __forceinline__ void attn_phase(char*lds,const AttnTensors&T,const Sched&S,lds_cptr btab,unsigned mhalf_bits){
  AttnUnit u;
  for(int i=0;S.next(i,u);++i){ S.a_ready(u); attn_unit<THRL>(u.bh/NHEAD,u.bh%NHEAD,u.qb,T.Q,T.K,T.V,T.O,lds,btab,mhalf_bits); S.done(u); }
}
#undef SBAR
#undef WAIT_BAR
}
#define XB_TMO      128
#define XB_XCNT(j)  (256  + 64 * (j))
#define XB_XSUB(j)  (1280 + 64 * (j))
#define XB_XGEN(j)  (2304 + 64 * (j))
#define XB_TOP      3328
#define XB_TOPGEN   3392
#define XCD_BAR_WORDS 3456
#define XB_SPIN_CAP (1u << 18)

__device__ __forceinline__ unsigned xb_ld(unsigned* p)              { return __hip_atomic_load(p, __ATOMIC_RELAXED, __HIP_MEMORY_SCOPE_AGENT); }
__device__ __forceinline__ unsigned xb_add(unsigned* p, unsigned v) { return __hip_atomic_fetch_add(p, v, __ATOMIC_RELAXED, __HIP_MEMORY_SCOPE_AGENT); }
__device__ __forceinline__ unsigned xb_xcc_id() { return (unsigned)__builtin_amdgcn_s_getreg((3 << 11) | 20) & 0xFu; }
#define XB_SPIN(cond, bar) do { unsigned _sp = 0; while (cond) { __builtin_amdgcn_s_sleep(1); \
    if ((++_sp & 255u) == 0u) { if (xb_ld(&(bar)[XB_TMO])) break; if (_sp > XB_SPIN_CAP) { atomicAdd(&(bar)[XB_TMO], 1u); break; } } } } while (0)

struct XcdBarrier {
    unsigned* bar; unsigned x;
    volatile LAS unsigned* st;
};

__device__ __forceinline__ XcdBarrier xcd_barrier_post(unsigned* bar, volatile LAS unsigned* st) {
    XcdBarrier b; b.bar = bar; b.x = xb_xcc_id(); b.st = st;
    if (threadIdx.x == 0) (void)xb_add(&bar[XB_XCNT(b.x)], 1u);
    return b;
}
__device__ __forceinline__ void xcd_barrier_complete(unsigned* bar, unsigned x, unsigned& nloc, unsigned& nx) {
    const unsigned G = gridDim.x * gridDim.y * gridDim.z;
    unsigned sum, cnt, mine, sp = 0u;
    for (;;) {
        sum = 0u; cnt = 0u; mine = 0u;
#pragma unroll
        for (unsigned j = 0; j < 16; ++j) { const unsigned c = xb_ld(&bar[XB_XCNT(j)]); sum += c; cnt += (c > 0u) ? 1u : 0u; mine = (j == x) ? c : mine; }
        if (sum == G) break;
        __builtin_amdgcn_s_sleep(1);
        if ((++sp & 255u) == 0u) { if (xb_ld(&bar[XB_TMO])) break; if (sp > XB_SPIN_CAP) { atomicAdd(&bar[XB_TMO], 1u); break; } }
    }
    nloc = mine > 0u ? mine : 1u; nx = cnt > 0u ? cnt : 1u;
}

__device__ __forceinline__ void xcd_barrier(const XcdBarrier& b) {
    asm volatile("s_waitcnt vmcnt(0)" ::: "memory");
    __syncthreads();
    if (threadIdx.x == 0) {
        unsigned* bar = b.bar;
        __builtin_amdgcn_s_waitcnt(0);
        unsigned nloc = b.st[0], nx = b.st[1];
        if (nloc == 0u) { xcd_barrier_complete(bar, b.x, nloc, nx); b.st[0] = nloc; b.st[1] = nx; }
        const unsigned old = xb_add(&bar[XB_XSUB(b.x)], 1u);
        const unsigned gen = old / nloc;
        if (old + 1u == (gen + 1u) * nloc) {
            __builtin_amdgcn_fence(__ATOMIC_RELEASE, "agent");
            asm volatile("s_waitcnt vmcnt(0)" ::: "memory");
            const unsigned og = xb_add(&bar[XB_TOP], 1u);
            const unsigned tg = og / nx;
            if (og + 1u == (tg + 1u) * nx) xb_add(&bar[XB_TOPGEN], 1u);
            else XB_SPIN(xb_ld(&bar[XB_TOPGEN]) == tg, bar);
            __builtin_amdgcn_fence(__ATOMIC_ACQUIRE, "agent");
            xb_add(&bar[XB_XGEN(b.x)], 1u);
            asm volatile("s_waitcnt vmcnt(0)" ::: "memory");
        } else {
            XB_SPIN(xb_ld(&bar[XB_XGEN(b.x)]) == gen, bar);
            __builtin_amdgcn_fence(__ATOMIC_ACQUIRE, "agent");
            asm volatile("s_waitcnt vmcnt(0)" ::: "memory");
        }
    }
    __syncthreads();
}

struct Frame {
    LAS unsigned char* lds;
    volatile LAS unsigned* MISC;
    gu32* ctl;
    int tid, lane, wave, vcu, G;
    const float *x_p, *x_s, *state_conv, *cache_k, *cache_v, *cache_lf, *norm_ffn, *ffn_w_in, *ffn_w_out, *norm_mix, *conv_w_in, *conv_w, *conv_w_out, *attn_w_in, *attn_bf, *q_norm, *k_norm, *attn_w_out;
    float* out; unsigned char* ws;
};
__device__ __forceinline__ bf16* ws_bf(const Frame& F, size_t off) { return (bf16*)(F.ws + off); }

__device__ __forceinline__ float wave_sum(float v) {
#pragma unroll
    for (int o = 1; o < 64; o <<= 1) v += __shfl_xor(v, o);
    return v;
}

__device__ __forceinline__ void wprep_item(const float* W, int ldw, int K, const float* gain, int col0, int nvalid, bf16* WT, int dst_row0, int kb, LAS float* scr, int lane) {
    const int k0 = 64 * kb, c = lane & 31;
    float v[32];
    const float* wp = W + (size_t)(k0 + (lane >> 5)) * ldw + col0 + c;
    if (c < nvalid) {
#pragma unroll
        for (int i = 0; i < 32; ++i) v[i] = __builtin_nontemporal_load(wp + (size_t)(2 * i) * ldw);
    } else {
#pragma unroll
        for (int i = 0; i < 32; ++i) v[i] = 0.f;
    }
    if (gain) {
#pragma unroll
        for (int i = 0; i < 32; ++i) v[i] *= gain[k0 + 2 * i + (lane >> 5)];
    }
#pragma unroll
    for (int i = 0; i < 32; ++i) scr[(2 * i + (lane >> 5)) * 33 + c] = v[i];
    LDS_WAIT(); asm volatile("" ::: "memory");
    const int c8 = lane & 7;
#pragma unroll
    for (int j = 0; j < 4; ++j) { const int n = (lane >> 3) + 8 * j; const LAS float* s = scr + (8 * c8) * 33 + n;
        v4u o; o.x = pk2(s[0 * 33], s[1 * 33]); o.y = pk2(s[2 * 33], s[3 * 33]); o.z = pk2(s[4 * 33], s[5 * 33]); o.w = pk2(s[6 * 33], s[7 * 33]);
        *(GAS v4u*)(WT + (size_t)(dst_row0 + n) * K + k0 + 8 * c8) = o; }
    LDS_WAIT(); asm volatile("" ::: "memory");
}
__device__ __forceinline__ int pair_col(int g, int base, int half_off) { const int tile = g >> 3, bj = (g >> 2) & 1, i = g & 3; return base + bj * half_off + 128 * tile + 32 * i; }
__device__ __forceinline__ int head_col(int g) { const int tile = g >> 3, bj = (g >> 2) & 1, wc = g & 3; return 256 * tile + 64 * wc + 32 * bj; }

__device__ __forceinline__ void p0_prologue(Frame& F) {
    LAS float* scr = (LAS float*)(F.lds + RING_OFF + F.wave * 16384);
    const int gw = F.vcu * NWAVES + F.wave, NGW = F.G * NWAVES, lane = F.lane;
    constexpr int KB1 = D / 64, KB2 = FF / 64;
    constexpr int I_FFI = (2 * FF / 32) * KB1, I_FFO = (D / 32) * KB2;
    constexpr int I_CI1 = 32 * KB1, I_CI2 = 64 * KB1, I_CO = 32 * KB1, I_AQK = 64 * KB1, I_AV = 32 * KB1, I_AF = 8 * KB1, I_AO = 32 * KB1;
    constexpr int NITEMS = 4 * I_FFI + 4 * I_FFO + I_CI1 + I_CI2 + I_CO + I_AQK + I_AV + I_AF + I_AO;
    for (int it = gw; it < NITEMS; it += NGW) {
        int r = it;
        if (r < 4 * I_FFI) { const int w = r / I_FFI; r -= w * I_FFI; const int g = r / KB1, kb = r % KB1;
            wprep_item(F.ffn_w_in + (size_t)w * D * 2 * FF, 2 * FF, D, F.norm_ffn + w * D, pair_col(g, 0, FF), 32, ws_bf(F, WS_FFI + w * SZ_FFI), 32 * g, kb, scr, lane); continue; }
        r -= 4 * I_FFI;
        if (r < 4 * I_FFO) { const int w = r / I_FFO; r -= w * I_FFO; const int g = r / KB2, kb = r % KB2;
            wprep_item(F.ffn_w_out + (size_t)w * FF * D, D, FF, nullptr, 32 * g, 32, ws_bf(F, WS_FFO + w * SZ_FFO), 32 * g, kb, scr, lane); continue; }
        r -= 4 * I_FFO;
        if (r < I_CI1) { const int g = r / KB1, kb = r % KB1; wprep_item(F.conv_w_in, 3 * D, D, F.norm_mix, 32 * g, 32, ws_bf(F, WS_CI), 32 * g, kb, scr, lane); continue; }
        r -= I_CI1;
        if (r < I_CI2) { const int g = r / KB1, kb = r % KB1; wprep_item(F.conv_w_in, 3 * D, D, F.norm_mix, pair_col(g, D, D), 32, ws_bf(F, WS_CI), D + 32 * g, kb, scr, lane); continue; }
        r -= I_CI2;
        if (r < I_CO) { const int g = r / KB1, kb = r % KB1; wprep_item(F.conv_w_out, D, D, nullptr, 32 * g, 32, ws_bf(F, WS_CO), 32 * g, kb, scr, lane); continue; }
        r -= I_CO;
        if (r < I_AQK) { const int g = r / KB1, kb = r % KB1; wprep_item(F.attn_w_in, 3 * D + NH, D, F.norm_mix + D, head_col(g), 32, ws_bf(F, WS_AI), 32 * g, kb, scr, lane); continue; }
        r -= I_AQK;
        if (r < I_AV) { const int g = r / KB1, kb = r % KB1; wprep_item(F.attn_w_in, 3 * D + NH, D, F.norm_mix + D, 2 * D + 32 * g, 32, ws_bf(F, WS_AI), 2 * D + 32 * g, kb, scr, lane); continue; }
        r -= I_AV;
        if (r < I_AF) { const int g = r / KB1, kb = r % KB1; wprep_item(F.attn_w_in, 3 * D + NH, D, F.norm_mix + D, 3 * D, g == 0 ? NH : 0, ws_bf(F, WS_AI), 3 * D + 32 * g, kb, scr, lane); continue; }
        r -= I_AF;
        { const int g = r / KB1, kb = r % KB1; wprep_item(F.attn_w_out, D, D, nullptr, 32 * g, 32, ws_bf(F, WS_AO), 32 * g, kb, scr, lane); }
    }
    bf16* XB = ws_bf(F, WS_XB); float* RS = (float*)(F.ws + WS_RS);
    for (int m = gw; m < M; m += NGW) {
        const float* src = m < MP ? F.x_p + (size_t)m * D : F.x_s + (size_t)(m - MP) * D;
        const GAS pg8::f32x4* xr = (const GAS pg8::f32x4*)src + lane; float ss = 0.f;
        GAS unsigned long long* o8 = (GAS unsigned long long*)(XB + (size_t)m * D) + lane;
        pg8::f32x4 xv[4];
#pragma unroll
        for (int j = 0; j < 4; ++j) xv[j] = xr[64 * j];
#pragma unroll
        for (int j = 0; j < 4; ++j) { const pg8::f32x4 v = xv[j]; ss += (v[0] * v[0] + v[1] * v[1]) + (v[2] * v[2] + v[3] * v[3]);
            o8[64 * j] = (unsigned long long)pk2(v[0], v[1]) | ((unsigned long long)pk2(v[2], v[3]) << 32); }
        ss = wave_sum(ss);
        if (m < MP) { if (lane == 0) *(pg8::f32x4*)(RS + (size_t)m * 4) = (pg8::f32x4){ss, 0.f, 0.f, 0.f}; }
        else if (lane < 4) *(pg8::f32x4*)(RS + (size_t)MP * 4 + (size_t)(m - MP) * 16 + 4 * lane) = (pg8::f32x4){lane == 0 ? ss : 0.f, 0.f, 0.f, 0.f};
    }
}

__device__ __forceinline__ void unpack8(const v4u w, float (&f)[8]) { f[0] = bflo(w.x); f[1] = bfhi(w.x); f[2] = bflo(w.y); f[3] = bfhi(w.y); f[4] = bflo(w.z); f[5] = bfhi(w.z); f[6] = bflo(w.w); f[7] = bfhi(w.w); }
__device__ __forceinline__ void conv_ew_phase(Frame& F) {
    bf16* G = ws_bf(F, WS_BIG); const bf16* U = ws_bf(F, WS_BIG + SZ_ACT);
    const int gw = F.vcu * NWAVES + F.wave, NGW = F.G * NWAVES, lane = F.lane;
    constexpr int RCH = 16, NITEMS = (M / RCH) * 2;
    for (int it = gw; it < NITEMS; it += NGW) {
        const int r0 = (it >> 1) * RCH, c = (it & 1) * 512 + lane * 8;
        float w0[8], w1[8], w2[8], um2[8], um1[8];
#pragma unroll
        for (int j = 0; j < 8; ++j) { w0[j] = F.conv_w[c + j]; w1[j] = F.conv_w[D + c + j]; w2[j] = F.conv_w[2 * D + c + j]; }
        int t0, b; bool prompt = r0 < MP;
        if (prompt) { t0 = r0 & (SEQ - 1); b = r0 >> 11; } else { t0 = (r0 - MP) & (DSEQ - 1); b = (r0 - MP) >> 6; }
        if (t0 == 0) {
            if (prompt) {
#pragma unroll
                for (int j = 0; j < 8; ++j) { um2[j] = 0.f; um1[j] = 0.f; }
            } else {
#pragma unroll
                for (int j = 0; j < 8; ++j) { um2[j] = F.state_conv[((size_t)b * 2 + 0) * D + c + j]; um1[j] = F.state_conv[((size_t)b * 2 + 1) * D + c + j]; }
            }
        } else {
            unpack8(*(const GAS v4u*)(U + (size_t)(r0 - 2) * D + c), um2); unpack8(*(const GAS v4u*)(U + (size_t)(r0 - 1) * D + c), um1);
        }
        for (int i = 0; i < RCH; ++i) {
            float uc[8], gg[8], z[8];
            unpack8(*(const GAS v4u*)(U + (size_t)(r0 + i) * D + c), uc); unpack8(*(const GAS v4u*)(G + (size_t)(r0 + i) * D + c), gg);
#pragma unroll
            for (int j = 0; j < 8; ++j) { z[j] = gg[j] * (w0[j] * um2[j] + w1[j] * um1[j] + w2[j] * uc[j]); um2[j] = um1[j]; um1[j] = uc[j]; }
            v4u o; o.x = pk2(z[0], z[1]); o.y = pk2(z[2], z[3]); o.z = pk2(z[4], z[5]); o.w = pk2(z[6], z[7]);
            *(GAS v4u*)(G + (size_t)(r0 + i) * D + c) = o;
        }
    }
}

template <int FMT  >
__device__ __forceinline__ void cumsum_table(const float* s1, int n1, const float* s2, int n2, LAS float* tab, LAS float* wsum, int tid) {
    asm volatile("" : "+v"(tid));
    const int lane = tid & 63, wid = tid >> 6;
    float v[5]; float run = 0.f;
#pragma unroll
    for (int j = 0; j < 5; ++j) { const int e = 5 * tid + j; float x = 0.f; if (e < n1) x = s1[(size_t)e * NH]; else if (e < n1 + n2) x = s2[(size_t)(e - n1) * NH]; run += x; v[j] = run; }
    float sc = run;
#pragma unroll
    for (int o = 1; o < 64; o <<= 1) { const float t = __shfl_up(sc, o); if (lane >= o) sc += t; }
    if (lane == 63) wsum[wid] = sc;
    __syncthreads();
    float off = 0.f;
    for (int w = 0; w < wid; ++w) off += wsum[w];
    const float excl = off + sc - run;
#pragma unroll
    for (int j = 0; j < 5; ++j) { const int e = 5 * tid + j; if (e < n1 + n2) { const float bias = -(excl + v[j]) * LOG2E;
        if (FMT == 0) tab[e] = bias;
        else { const float hb = 0.5f * bias;
               const unsigned p1 = f2bf(hb); const float r1 = hb - bf2f((unsigned short)p1); const unsigned p2 = f2bf(r1); const float r2 = r1 - bf2f((unsigned short)p2); const unsigned p3 = f2bf(r2);
            ((LAS v4u*)tab)[e] = (v4u){p1 | (p2 << 16), p3 | 0x3F800000u, 0x3F803F80u, 0x00003F80u}; } } }
    __syncthreads();
}

__device__ __forceinline__ void attn_simple_phase(Frame& F, bool do_prompt) {
    bf16* Qb = ws_bf(F, WS_BIG); const bf16* Kb = ws_bf(F, WS_BIG + SZ_ACT); const bf16* Vb = ws_bf(F, WS_BIG + 2 * SZ_ACT);
    LAS float* tab = (LAS float*)(F.lds + RING_OFF); LAS float* wsum = (LAS float*)(F.lds + RING_OFF + 16384);
    const int lane = F.lane;
    for (int bh = F.vcu >> 1; bh < NB * NH; bh += F.G >> 1) {
        const int b = bh >> 4, h = bh & 15, half = F.vcu & 1;
        __syncthreads();
        if (do_prompt) cumsum_table<0>(F.out + O_LFP + (size_t)b * SEQ * NH + h, SEQ, nullptr, 0, tab, wsum, F.tid);
        for (int i = F.wave; do_prompt && i < 16; i += NWAVES) {
            const int tb = 2 * i + half, t = tb * 64 + lane; const size_t row = (size_t)b * SEQ + t;
            float q[64], o[64];
#pragma unroll
            for (int d = 0; d < 64; d += 8) { float f[8]; unpack8(*(const GAS v4u*)(Qb + row * D + h * HD + d), f);
#pragma unroll
                for (int j = 0; j < 8; ++j) { q[d + j] = f[j]; o[d + j] = 0.f; } }
            float mx = -1e30f, l = 0.f;
            const int kend = tb * 64 + 63;
            for (int k = 0; k <= kend; ++k) {
                const size_t kr = ((size_t)b * SEQ + k) * D + h * HD;
                float s = 0.f;
#pragma unroll
                for (int d = 0; d < 64; d += 8) { float f[8]; unpack8(*(const GAS v4u*)(Kb + kr + d), f);
#pragma unroll
                    for (int j = 0; j < 8; ++j) s += q[d + j] * f[j]; }
                s += tab[k];
                if (k > t) s = -1e30f;
                const float mn = fmaxf(mx, s), al = __builtin_amdgcn_exp2f(mx - mn), p = (k > t) ? 0.f : __builtin_amdgcn_exp2f(s - mn);
                mx = mn; l = l * al + p;
#pragma unroll
                for (int d = 0; d < 64; d += 8) { float f[8]; unpack8(*(const GAS v4u*)(Vb + kr + d), f);
#pragma unroll
                    for (int j = 0; j < 8; ++j) o[d + j] = o[d + j] * al + p * f[j]; }
            }
            const float il = 1.0f / l;
#pragma unroll
            for (int d = 0; d < 64; d += 8) { v4u w; w.x = pk2(o[d] * il, o[d + 1] * il); w.y = pk2(o[d + 2] * il, o[d + 3] * il); w.z = pk2(o[d + 4] * il, o[d + 5] * il); w.w = pk2(o[d + 6] * il, o[d + 7] * il);
                *(GAS v4u*)(Qb + row * D + h * HD + d) = w; }
        }
        if (half == 0) {
            __syncthreads();
            cumsum_table<0>(F.cache_lf + (size_t)b * PAST * NH + h, PAST, F.out + O_LFS + (size_t)b * DSEQ * NH + h, DSEQ, tab, wsum, F.tid);
            if (F.wave == 0) {
                const int t = lane; const size_t row = (size_t)MP + (size_t)b * DSEQ + t;
                float q[64], o[64];
#pragma unroll
                for (int d = 0; d < 64; d += 8) { float f[8]; unpack8(*(const GAS v4u*)(Qb + row * D + h * HD + d), f);
#pragma unroll
                    for (int j = 0; j < 8; ++j) { q[d + j] = f[j]; o[d + j] = 0.f; } }
                float mx = -1e30f, l = 0.f;
                for (int k = 0; k < PAST; ++k) {
                    const float* kp = F.cache_k + (((size_t)b * PAST + k) * NH + h) * HD; const float* vp = F.cache_v + (((size_t)b * PAST + k) * NH + h) * HD;
                    float s = 0.f;
#pragma unroll
                    for (int d = 0; d < 64; d += 4) { const pg8::f32x4 f = *(const GAS pg8::f32x4*)(kp + d); s += q[d] * f[0] + q[d + 1] * f[1] + q[d + 2] * f[2] + q[d + 3] * f[3]; }
                    s += tab[k];
                    const float mn = fmaxf(mx, s), al = __builtin_amdgcn_exp2f(mx - mn), p = __builtin_amdgcn_exp2f(s - mn);
                    mx = mn; l = l * al + p;
#pragma unroll
                    for (int d = 0; d < 64; d += 4) { const pg8::f32x4 f = *(const GAS pg8::f32x4*)(vp + d); o[d] = o[d] * al + p * f[0]; o[d + 1] = o[d + 1] * al + p * f[1]; o[d + 2] = o[d + 2] * al + p * f[2]; o[d + 3] = o[d + 3] * al + p * f[3]; }
                }
                for (int k = 0; k < DSEQ; ++k) {
                    const size_t kr = ((size_t)MP + (size_t)b * DSEQ + k) * D + h * HD;
                    float s = 0.f;
#pragma unroll
                    for (int d = 0; d < 64; d += 8) { float f[8]; unpack8(*(const GAS v4u*)(Kb + kr + d), f);
#pragma unroll
                        for (int j = 0; j < 8; ++j) s += q[d + j] * f[j]; }
                    s += tab[PAST + k];
                    if (k > t) s = -1e30f;
                    const float mn = fmaxf(mx, s), al = __builtin_amdgcn_exp2f(mx - mn), p = (k > t) ? 0.f : __builtin_amdgcn_exp2f(s - mn);
                    mx = mn; l = l * al + p;
#pragma unroll
                    for (int d = 0; d < 64; d += 8) { float f[8]; unpack8(*(const GAS v4u*)(Vb + kr + d), f);
#pragma unroll
                        for (int j = 0; j < 8; ++j) o[d + j] = o[d + j] * al + p * f[j]; }
                }
                const float il = 1.0f / l;
#pragma unroll
                for (int d = 0; d < 64; d += 8) { v4u w; w.x = pk2(o[d] * il, o[d + 1] * il); w.y = pk2(o[d + 2] * il, o[d + 3] * il); w.z = pk2(o[d + 4] * il, o[d + 5] * il); w.w = pk2(o[d + 6] * il, o[d + 7] * il);
                    *(GAS v4u*)(Qb + row * D + h * HD + d) = w; }
            }
        }
    }
    __syncthreads();
}

__device__ __forceinline__ void attn_fast_phase(Frame& F, unsigned char* lds_generic, bf16* Oout) {
    constexpr int BT_OFF = 86016, ZB_OFF = BT_OFF + 32768, WS_OFF = ZB_OFF + 1024;
    static_assert(attn_body::ATTN_LDS_BYTES <= BT_OFF && WS_OFF + 64 <= RING_BYTES, "attention LDS map");
    const attn_body::AttnTensors AT{(const attn_body::bf16*)ws_bf(F, WS_BIG), (const attn_body::bf16*)ws_bf(F, WS_BIG + SZ_ACT), (const attn_body::bf16*)ws_bf(F, WS_BIG + 2 * SZ_ACT), (attn_body::bf16*)Oout};
    unsigned mhalf_bits;
    { float gm = fmaxf(fabsf(F.q_norm[F.lane & 63]), 0.f), km = fabsf(F.k_norm[F.lane & 63]);
#pragma unroll
      for (int o = 1; o < 64; o <<= 1) { gm = fmaxf(gm, __shfl_xor(gm, o)); km = fmaxf(km, __shfl_xor(km, o)); }
      const float hb = 0.5f * 64.0f * gm * km * QSCALE; unsigned pb = f2bf(hb); if (bf2f((unsigned short)pb) < hb) pb += 1u;
      mhalf_bits = (pb | 0x8000u) & 0xffffu; }
    for (int v = F.vcu; v < 2 * NB * NH; v += F.G) {
        const int bh = v >> 1, b = bh >> 4, h = bh & 15;
        __syncthreads();
        cumsum_table<1>(F.out + O_LFP + (size_t)b * SEQ * NH + h, SEQ, nullptr, 0, (LAS float*)(F.lds + BT_OFF), (LAS float*)(F.lds + WS_OFF), F.tid);
        const attn_body::StaticOrder S(v);
        attn_body::attn_phase<attn_body::StaticOrder>((char*)lds_generic + RING_OFF, AT, S, (attn_body::lds_cptr)(F.lds + BT_OFF), mhalf_bits);
    }
}

typedef float sa_f32x16 __attribute__((ext_vector_type(16)));
__device__ __forceinline__ int sa_crow(int r, int hi) { return (r & 3) + 8 * (r >> 2) + 4 * hi; }
__device__ __forceinline__ unsigned sa_pk(float lo, float hi) { return pg8::cvt_pk_bf16(lo, hi); }
__device__ __forceinline__ void sa_tile(sa_f32x16& o0, sa_f32x16& o1, float& m, float& l, const pg8::bf16x8 (&qf)[4], const pg8::bf16x8 (&kf)[4], const pg8::bf16x8 (&vf)[2][2],
                                        const LAS float* tabk, int hi, int tq, int kn0) {
    sa_f32x16 p = {};
#pragma unroll
    for (int s = 0; s < 4; ++s) p = __builtin_amdgcn_mfma_f32_32x32x16_bf16(kf[s], qf[s], p, 0, 0, 0);
#pragma unroll
    for (int g = 0; g < 4; ++g) { const pg8::f32x4 bb = *(const LAS pg8::f32x4*)(tabk + 8 * g + 4 * hi);
#pragma unroll
        for (int j = 0; j < 4; ++j) p[4 * g + j] += bb[j]; }
    if (kn0 >= 0) {
#pragma unroll
        for (int r = 0; r < 16; ++r) if (kn0 + sa_crow(r, hi) > tq) p[r] = -1e30f;
    }
    float rm = p[0];
#pragma unroll
    for (int r = 1; r < 16; ++r) rm = fmaxf(rm, p[r]);
    rm = fmaxf(rm, __shfl_xor(rm, 32));
    const float mn = fmaxf(m, rm), al = __builtin_amdgcn_exp2f(m - mn);
    m = mn;
    float ls = 0.f;
#pragma unroll
    for (int r = 0; r < 16; ++r) { p[r] = __builtin_amdgcn_exp2f(p[r] - mn); ls += p[r]; }
    l = l * al + ls;
#pragma unroll
    for (int r = 0; r < 16; ++r) { o0[r] *= al; o1[r] *= al; }
    pg8::u32x4 w0, w1;
    w0.x = sa_pk(p[0], p[1]); w0.y = sa_pk(p[2], p[3]); w0.z = sa_pk(p[4], p[5]); w0.w = sa_pk(p[6], p[7]);
    w1.x = sa_pk(p[8], p[9]); w1.y = sa_pk(p[10], p[11]); w1.z = sa_pk(p[12], p[13]); w1.w = sa_pk(p[14], p[15]);
    const pg8::bf16x8 pf0 = __builtin_bit_cast(pg8::bf16x8, w0), pf1 = __builtin_bit_cast(pg8::bf16x8, w1);
    o0 = __builtin_amdgcn_mfma_f32_32x32x16_bf16(vf[0][0], pf0, o0, 0, 0, 0); o1 = __builtin_amdgcn_mfma_f32_32x32x16_bf16(vf[0][1], pf0, o1, 0, 0, 0);
    o0 = __builtin_amdgcn_mfma_f32_32x32x16_bf16(vf[1][0], pf1, o0, 0, 0, 0); o1 = __builtin_amdgcn_mfma_f32_32x32x16_bf16(vf[1][1], pf1, o1, 0, 0, 0);
}
__device__ __forceinline__ void attn_sample_fast(Frame& F, bf16* Oout) {
    constexpr int OW_OFF = 0, ML_OFF = 65536, TAB_OFF = ML_OFF + 2048, WS_OFF = TAB_OFF + 8704;
    static_assert(WS_OFF + 64 <= RING_BYTES, "decode attention LDS map");
    bf16* Qb = ws_bf(F, WS_BIG); const bf16* Kb = ws_bf(F, WS_BIG + SZ_ACT); const bf16* Vb = ws_bf(F, WS_BIG + 2 * SZ_ACT);
    int lane = F.lane; asm volatile("" : "+v"(lane));
    const int r32 = lane & 31, hi = lane >> 5, w = F.wave;
    LAS float* tab = (LAS float*)(F.lds + TAB_OFF);
    LAS float* ow = (LAS float*)(F.lds + OW_OFF);
    LAS float* mw = (LAS float*)(F.lds + ML_OFF);
    for (int v = F.vcu; v < 2 * NB * NH; v += F.G) {
        const int bh = v >> 1, qblk = v & 1, b = bh >> 4, h = bh & 15;
        __syncthreads();
        cumsum_table<0>(F.cache_lf + (size_t)b * PAST * NH + h, PAST, F.out + O_LFS + (size_t)b * DSEQ * NH + h, DSEQ, tab, (LAS float*)(F.lds + WS_OFF), F.tid);
        const size_t srow0 = (size_t)MP + (size_t)b * DSEQ;
        pg8::bf16x8 qf[4];
#pragma unroll
        for (int s = 0; s < 4; ++s) qf[s] = *(const pg8::bf16x8*)(Qb + (srow0 + 32 * qblk + r32) * D + h * HD + 16 * s + 8 * hi);
        sa_f32x16 o0 = {}, o1 = {}; float m = -1e30f, l = 0.f;
        const float* kbase = F.cache_k + (((size_t)b * PAST + r32) * NH + h) * HD + 8 * hi;
        const float* vbase = F.cache_v + (((size_t)b * PAST + 4 * hi) * NH + h) * HD + r32;
        pg8::f32x4 kr[4][2]; float vr[2][2][8];
        { const int key0 = 32 * (8 * w);
#pragma unroll
          for (int s = 0; s < 4; ++s) { kr[s][0] = *(const GAS pg8::f32x4*)(kbase + (size_t)key0 * D + 16 * s); kr[s][1] = *(const GAS pg8::f32x4*)(kbase + (size_t)key0 * D + 16 * s + 4); }
#pragma unroll
          for (int s = 0; s < 2; ++s)
#pragma unroll
            for (int j = 0; j < 8; ++j) { const float* vp = vbase + (size_t)(key0 + 16 * s + 8 * (j >> 2) + (j & 3)) * D; vr[s][0][j] = vp[0]; vr[s][1][j] = vp[32]; } }
        for (int i = 0; i < 8; ++i) {
            const int key0 = 32 * (8 * w + i);
            pg8::bf16x8 kf[4], vf[2][2];
#pragma unroll
            for (int s = 0; s < 4; ++s) { pg8::u32x4 t; t.x = sa_pk(kr[s][0][0], kr[s][0][1]); t.y = sa_pk(kr[s][0][2], kr[s][0][3]); t.z = sa_pk(kr[s][1][0], kr[s][1][1]); t.w = sa_pk(kr[s][1][2], kr[s][1][3]); kf[s] = __builtin_bit_cast(pg8::bf16x8, t); }
#pragma unroll
            for (int s = 0; s < 2; ++s)
#pragma unroll
                for (int d = 0; d < 2; ++d) { pg8::u32x4 t; t.x = sa_pk(vr[s][d][0], vr[s][d][1]); t.y = sa_pk(vr[s][d][2], vr[s][d][3]); t.z = sa_pk(vr[s][d][4], vr[s][d][5]); t.w = sa_pk(vr[s][d][6], vr[s][d][7]); vf[s][d] = __builtin_bit_cast(pg8::bf16x8, t); }
            if (i + 1 < 8) { const int kn = key0 + 32;
#pragma unroll
                for (int s = 0; s < 4; ++s) { kr[s][0] = *(const GAS pg8::f32x4*)(kbase + (size_t)kn * D + 16 * s); kr[s][1] = *(const GAS pg8::f32x4*)(kbase + (size_t)kn * D + 16 * s + 4); }
#pragma unroll
                for (int s = 0; s < 2; ++s)
#pragma unroll
                    for (int j = 0; j < 8; ++j) { const float* vp = vbase + (size_t)(kn + 16 * s + 8 * (j >> 2) + (j & 3)) * D; vr[s][0][j] = vp[0]; vr[s][1][j] = vp[32]; } }
            sa_tile(o0, o1, m, l, qf, kf, vf, tab + key0, hi, 0, -1);
        }
        if (w <= qblk) {
            const int nt = w; pg8::bf16x8 kf[4], vf[2][2];
#pragma unroll
            for (int s = 0; s < 4; ++s) kf[s] = *(const pg8::bf16x8*)(Kb + (srow0 + 32 * nt + r32) * D + h * HD + 16 * s + 8 * hi);
#pragma unroll
            for (int s = 0; s < 2; ++s)
#pragma unroll
                for (int d = 0; d < 2; ++d) { unsigned short e[8];
#pragma unroll
                    for (int j = 0; j < 8; ++j) e[j] = Vb[(srow0 + 32 * nt + 16 * s + 8 * (j >> 2) + 4 * hi + (j & 3)) * D + h * HD + 32 * d + r32];
                    pg8::u32x4 t; t.x = e[0] | ((unsigned)e[1] << 16); t.y = e[2] | ((unsigned)e[3] << 16); t.z = e[4] | ((unsigned)e[5] << 16); t.w = e[6] | ((unsigned)e[7] << 16); vf[s][d] = __builtin_bit_cast(pg8::bf16x8, t); }
            sa_tile(o0, o1, m, l, qf, kf, vf, tab + PAST + 32 * nt, hi, 32 * qblk + r32, 32 * nt);
        }
        l += __shfl_xor(l, 32);
        if (hi == 0) { mw[w * 32 + r32] = m; mw[256 + w * 32 + r32] = l; }
#pragma unroll
        for (int r = 0; r < 16; ++r) { const int d = sa_crow(r, hi); ow[(w * 64 + d) * 32 + r32] = o0[r]; ow[(w * 64 + 32 + d) * 32 + r32] = o1[r]; }
        __syncthreads();
        { const int q = F.tid & 31, d0 = (F.tid >> 5) * 4;
          float mm = mw[q]; float sc[8];
#pragma unroll
          for (int ww = 1; ww < 8; ++ww) mm = fmaxf(mm, mw[ww * 32 + q]);
          float L = 0.f;
#pragma unroll
          for (int ww = 0; ww < 8; ++ww) { sc[ww] = __builtin_amdgcn_exp2f(mw[ww * 32 + q] - mm); L += mw[256 + ww * 32 + q] * sc[ww]; }
          const float il = 1.0f / L; float acc[4] = {0.f, 0.f, 0.f, 0.f};
#pragma unroll
          for (int ww = 0; ww < 8; ++ww)
#pragma unroll
              for (int dd = 0; dd < 4; ++dd) acc[dd] += ow[(ww * 64 + d0 + dd) * 32 + q] * sc[ww];
          v2u o; o.x = pk2(acc[0] * il, acc[1] * il); o.y = pk2(acc[2] * il, acc[3] * il);
          *(GAS v2u*)(Oout + (srow0 + 32 * qblk + q) * D + h * HD + d0) = o; }
    }
    __syncthreads();
}

template <int K, int NN>
__device__ __forceinline__ void small_tile_mma(const bf16* A, int row0, const bf16* Bt, int g0, int g1, LAS float* part, int wave, int lane) {
    constexpr int KS = K / 8, NST = KS / 32;
    const int fr = lane & 15, fq = lane >> 4;
    const bf16* ap = A + (size_t)(row0 + fr) * K + wave * KS + 8 * fq;
    const bf16* bp0 = Bt + (size_t)(g0 + fr) * K + wave * KS + 8 * fq;
    const bf16* bp1 = Bt + (size_t)(g1 + fr) * K + wave * KS + 8 * fq;
    pg8::f32x4 acc[2][NN];
#pragma unroll
    for (int m = 0; m < 2; ++m)
#pragma unroll
        for (int n = 0; n < NN; ++n) acc[m][n] = (pg8::f32x4){0.f, 0.f, 0.f, 0.f};
#pragma unroll (NST > 6 ? 6 : NST)
    for (int st = 0; st < NST; ++st) {
        pg8::bf16x8 a[2], b[NN];
        a[0] = *(const pg8::bf16x8*)(ap + st * 32); a[1] = *(const pg8::bf16x8*)(ap + (size_t)16 * K + st * 32);
#pragma unroll
        for (int n = 0; n < NN; ++n) b[n] = *(const pg8::bf16x8*)((n < 2 ? bp0 + (size_t)(16 * n) * K : bp1 + (size_t)(16 * (n - 2)) * K) + st * 32);
#pragma unroll
        for (int m = 0; m < 2; ++m)
#pragma unroll
            for (int n = 0; n < NN; ++n) acc[m][n] = __builtin_amdgcn_mfma_f32_16x16x32_bf16(b[n], a[m], acc[m][n], 0, 0, 0);
    }
    __syncthreads();
#pragma unroll
    for (int m = 0; m < 2; ++m)
#pragma unroll
        for (int n = 0; n < NN; ++n) *(LAS pg8::f32x4*)(part + ((wave * 32 + 16 * m + fr) * 64 + 16 * n + 4 * fq)) = acc[m][n];
    __syncthreads();
}
__device__ __forceinline__ pg8::f32x4 sm_sum(const LAS float* part, int row, int col) {
    pg8::f32x4 s = *(const LAS pg8::f32x4*)(part + row * 64 + col);
#pragma unroll
    for (int w = 1; w < 8; ++w) s += *(const LAS pg8::f32x4*)(part + (w * 32 + row) * 64 + col);
    return s;
}
__device__ __forceinline__ float row16_sum(float v) { v += __shfl_xor(v, 1); v += __shfl_xor(v, 2); v += __shfl_xor(v, 4); v += __shfl_xor(v, 8); return v; }
__device__ __forceinline__ v2u pk4(const pg8::f32x4 v) { v2u o; o.x = pg8::cvt_pk_bf16(v[0], v[1]); o.y = pg8::cvt_pk_bf16(v[2], v[3]); return o; }

template <int K, bool BASE_F32, bool OUT_F32>
__device__ __forceinline__ void small_out_proj(Frame& F, const bf16* A, const bf16* Bt, const float* base_s, float scale) {
    LAS float* part = (LAS float*)(F.lds + RING_OFF);
    float* X = F.out + O_Y; bf16* XB = ws_bf(F, WS_XB); float* RSs = (float*)(F.ws + WS_RS) + (size_t)MP * 4;
    for (int t = F.vcu; t < 256; t += F.G) {
        const int xq = t >> 5, j = t & 31, rg = (xq & 1) * 8 + (j >> 2), ct = (xq >> 1) * 4 + (j & 3), row0 = MP + 32 * rg;
        small_tile_mma<K, 4>(A, row0, Bt, 64 * ct, 64 * ct + 32, part, F.wave, F.lane);
        const int rl = F.tid >> 4, q = F.tid & 15, row = row0 + rl, col = 64 * ct + 4 * q;
        const pg8::f32x4 a = sm_sum(part, rl, 4 * q);
        pg8::f32x4 b;
        if (BASE_F32) b = *(const pg8::f32x4*)(base_s + (size_t)(row - MP) * D + col);
        else { const v2u wb = *(const v2u*)(XB + (size_t)row * D + col); b = (pg8::f32x4){bflo(wb.x), bfhi(wb.x), bflo(wb.y), bfhi(wb.y)}; }
        const pg8::f32x4 v = b + a * scale;
        if (OUT_F32) *(pg8::f32x4*)(X + (size_t)row * D + col) = v;
        else {
            *(v2u*)(XB + (size_t)row * D + col) = pk4(v);
            const float ss = row16_sum((v[0] * v[0] + v[1] * v[1]) + (v[2] * v[2] + v[3] * v[3]));
            if (q == 0) RSs[(size_t)(row - MP) * 16 + ct] = ss;
        }
    }
    __syncthreads();
}
__device__ __forceinline__ void small_conv_in(Frame& F) {
    LAS float* part = (LAS float*)(F.lds + RING_OFF);
    const bf16* XB = ws_bf(F, WS_XB); const bf16* Bt = ws_bf(F, WS_CI); bf16* G = ws_bf(F, WS_BIG); bf16* U = ws_bf(F, WS_BIG + SZ_ACT); const float* RS = (const float*)(F.ws + WS_RS);
    for (int t = F.vcu; t < 768; t += F.G) {
        const int rl = F.tid >> 4, q = F.tid & 15;
        if (t < 256) {
            const int rg = t >> 4, ct = t & 15, row0 = MP + 32 * rg, row = row0 + rl;
            small_tile_mma<D, 4>(XB, row0, Bt, 64 * ct, 64 * ct + 32, part, F.wave, F.lane);
            const float r = mk::row_rstd(RS, row);
            *(v2u*)(G + (size_t)row * D + 64 * ct + 4 * q) = pk4(sm_sum(part, rl, 4 * q) * r);
        } else {
            const int tt = t - 256, rg = tt >> 5, j = tt & 31, row0 = MP + 32 * rg, row = row0 + rl, g0 = D + 256 * (j >> 2) + 32 * (j & 3);
            small_tile_mma<D, 4>(XB, row0, Bt, g0, g0 + 128, part, F.wave, F.lane);
            if (q < 8) {
                const float r = mk::row_rstd(RS, row);
                const pg8::f32x4 u = sm_sum(part, rl, 4 * q) * sm_sum(part, rl, 32 + 4 * q) * (r * r);
                const int col = 32 * j + 4 * q;
                *(v2u*)(U + (size_t)row * D + col) = pk4(u);
                const int rr = row - MP, tq = rr & (DSEQ - 1);
                if (tq >= DSEQ - 2) *(pg8::f32x4*)(F.out + O_CSS + ((size_t)(rr >> 6) * 2 + (tq - (DSEQ - 2))) * D + col) = u;
            }
        }
    }
    __syncthreads();
}
__device__ __forceinline__ void small_attn_in(Frame& F) {
    LAS float* part = (LAS float*)(F.lds + RING_OFF);
    const bf16* XB = ws_bf(F, WS_XB); const bf16* Bt = ws_bf(F, WS_AI); const float* RS = (const float*)(F.ws + WS_RS);
    bf16* Qb = ws_bf(F, WS_BIG); bf16* Kb = ws_bf(F, WS_BIG + SZ_ACT); bf16* Vb = ws_bf(F, WS_BIG + 2 * SZ_ACT);
    constexpr int NT_S = 16 * 48, NT_F = M / 32;
    for (int t = F.vcu; t < NT_S + NT_F; t += F.G) {
        const int rl = F.tid >> 4, q = F.tid & 15;
        if (t < NT_S) {
            const int rg = t / 48, c = t % 48, row0 = MP + 32 * rg, row = row0 + rl;
            if (c < 32) {
                const bool isq = c < 16; const int hh = c & 15, g0 = 256 * ((isq ? 0 : 4) + (hh >> 2)) + 32 * (hh & 3);
                small_tile_mma<D, 4>(XB, row0, Bt, g0, g0 + 128, part, F.wave, F.lane);
                const float r = mk::row_rstd(RS, row);
                const pg8::f32x4 a = sm_sum(part, rl, 4 * q);
                const float ss = row16_sum((a[0] * a[0] + a[1] * a[1]) + (a[2] * a[2] + a[3] * a[3]));
                const float f = r * rsqrtf(r * r * ss * (1.0f / HD) + NORM_EPS);
                const pg8::f32x4 gv = *(const pg8::f32x4*)((isq ? F.q_norm : F.k_norm) + 4 * q), o = a * f * gv;
                const size_t off = (size_t)row * D + hh * HD + 4 * q;
                if (isq) *(v2u*)(Qb + off) = pk4(o * QSCALE);
                else { *(v2u*)(Kb + off) = pk4(o); *(pg8::f32x4*)(F.out + O_KS + (size_t)(row - MP) * D + hh * HD + 4 * q) = o; }
            } else {
                const int ct = c - 32;
                small_tile_mma<D, 4>(XB, row0, Bt, 2 * D + 64 * ct, 2 * D + 64 * ct + 32, part, F.wave, F.lane);
                const float r = mk::row_rstd(RS, row);
                const pg8::f32x4 o = sm_sum(part, rl, 4 * q) * r;
                *(v2u*)(Vb + (size_t)row * D + 64 * ct + 4 * q) = pk4(o);
                *(pg8::f32x4*)(F.out + O_VS + (size_t)(row - MP) * D + 64 * ct + 4 * q) = o;
            }
        } else {
            const int row0 = 32 * (t - NT_S), row = row0 + rl;
            small_tile_mma<D, 1>(XB, row0, Bt, 3 * D, 3 * D, part, F.wave, F.lane);
            if (q < 4) {
                const float r = mk::row_rstd(RS, row);
                const pg8::f32x4 a = sm_sum(part, rl, 4 * q) * r + *(const pg8::f32x4*)(F.attn_bf + 4 * q);
                pg8::f32x4 lf;
#pragma unroll
                for (int j = 0; j < 4; ++j) lf[j] = mk::log_sigmoid(a[j]);
                float* lo = row < MP ? F.out + O_LFP + (size_t)row * NH : F.out + O_LFS + (size_t)(row - MP) * NH;
                *(pg8::f32x4*)(lo + 4 * q) = lf;
            }
        }
    }
    __syncthreads();
}

template <class Epi, class Sched>
__device__ __forceinline__ void run_gemm(Frame& F, const pg8::Gemm& g, const Sched& S, const Epi& E) {
#if MK_FAST_GEMM
    pg8::gemm_phase<Epi, Sched, Epi::AFTER_DRAIN ? false : PG8_ALIGN, PG8_SP2>(F.lds + RING_OFF, g, S, E);
#else
    mk::gemm_phase_simple<Epi, Sched>(F.lds + RING_OFF, g, S, E);
#endif
}
template <int K, bool BASE_F32, bool OUT_F32>
__device__ __forceinline__ void out_proj_phase(Frame& F, const bf16* A, const bf16* Bt, const float* base_p, const float* base_s, float scale) {
    float* X = F.out + O_Y;
    pg8::Gemm g{A, Bt, MP, D, K};
    mk::EpiRes<BASE_F32, OUT_F32> E{base_p, base_s, X, ws_bf(F, WS_XB), (float*)(F.ws + WS_RS), scale};
    const int nunits = (MP / 256) * (D / 256);
    for (int rnd = 0; rnd * F.G < nunits; ++rnd) {
        mk::RoundOrder S; S.init(MP, D, F.G, (int)blockIdx.x); S.rnd = rnd;
        run_gemm(F, g, S, E);
        __syncthreads();
    }
    small_out_proj<K, BASE_F32, OUT_F32>(F, A, Bt, base_s, scale);
}
__device__ __forceinline__ void ffn_in_phase(Frame& F, int w) {
    pg8::Gemm g{ws_bf(F, WS_XB), ws_bf(F, WS_FFI + (size_t)w * SZ_FFI), M, 2 * FF, D};
    pg8::StaticOrder S; S.init(M, 2 * FF, F.G, (int)blockIdx.x);
    mk::EpiSwiglu E{ws_bf(F, WS_H), (const float*)(F.ws + WS_RS)};
    run_gemm(F, g, S, E);
}

struct Args { const float* in[18]; float* out; unsigned char* ws; int ph_lo, ph_hi; };
__global__ void __launch_bounds__(NWAVES * 64, 2) mk_fwd(Args args) {
    extern __shared__ __attribute__((aligned(16))) unsigned char lds[];
    Frame F;
    F.lds = (LAS unsigned char*)lds;
    F.MISC = (volatile LAS unsigned*)(F.lds + MISC_OFF);
    F.tid = threadIdx.x; F.lane = F.tid & 63; F.wave = __builtin_amdgcn_readfirstlane(F.tid >> 6);
    F.G = gridDim.x; { const int bx = blockIdx.x; F.vcu = (F.G % 8 == 0) ? (bx % 8) * (F.G / 8) + bx / 8 : bx; }
    F.ws = args.ws; F.out = args.out; F.ctl = (gu32*)(args.ws + WS_CTL);
    F.x_p = args.in[0]; F.x_s = args.in[1]; F.state_conv = args.in[2]; F.cache_k = args.in[3]; F.cache_v = args.in[4]; F.cache_lf = args.in[5];
    F.norm_ffn = args.in[6]; F.ffn_w_in = args.in[7]; F.ffn_w_out = args.in[8]; F.norm_mix = args.in[9]; F.conv_w_in = args.in[10]; F.conv_w = args.in[11];
    F.conv_w_out = args.in[12]; F.attn_w_in = args.in[13]; F.attn_bf = args.in[14]; F.q_norm = args.in[15]; F.k_norm = args.in[16]; F.attn_w_out = args.in[17];
    for (int u = F.tid; u < (LDS_BYTES - LDSCTL_OFF) / 4; u += NWAVES * 64) ((LAS unsigned*)(F.lds + LDSCTL_OFF))[u] = 0u;
    __syncthreads();
#if MK_ONE_LAUNCH
    XcdBarrier bar = xcd_barrier_post((unsigned*)(F.ctl + CW_BAR), F.MISC + 8);
#define GRID_BAR() xcd_barrier(bar)
#else
#define GRID_BAR() do {} while (0)
#endif
    const int lo = args.ph_lo, hi = args.ph_hi;
#define IN(k) (lo <= (k) && (k) < hi)
#define SEAM(k) do { if (IN(k) && IN((k) + 1)) GRID_BAR(); } while (0)

#define PH(k, ...) if (IN(k)) { for (int rep_ = ((k) == MK_PROBE ? MK_PROBE_REPS : 0); rep_ >= 0; --rep_) { const bool extra_ = rep_ > 0; (void)extra_; \
        { int t_ = threadIdx.x; asm volatile("" : "+v"(t_)); F.tid = t_; F.lane = t_ & 63; F.wave = __builtin_amdgcn_readfirstlane(t_ >> 6); }     \
        __VA_ARGS__; if (extra_) GRID_BAR(); } } SEAM(k)
    PH(0, p0_prologue(F); VM_WAIT(); __syncthreads());
    PH(1, ffn_in_phase(F, 0));
    PH(2, out_proj_phase<FF, true, false>(F, ws_bf(F, WS_H), ws_bf(F, WS_FFO + 0 * SZ_FFO), F.x_p, F.x_s, 0.5f));
    PH(3, {
        pg8::Gemm g{ws_bf(F, WS_XB), ws_bf(F, WS_CI), MP, 3 * D, D};
        pg8::StaticOrder S; S.init(MP, 3 * D, F.G, (int)blockIdx.x);
        mk::EpiConvIn E{ws_bf(F, WS_BIG), ws_bf(F, WS_BIG + SZ_ACT), (const float*)(F.ws + WS_RS), F.out + O_CSP, F.out + O_CSS};
        run_gemm(F, g, S, E);
        __syncthreads();
        small_conv_in(F);
    });
    PH(4, conv_ew_phase(F));
    PH(5, out_proj_phase<D, false, false>(F, ws_bf(F, WS_BIG), ws_bf(F, WS_CO), nullptr, nullptr, extra_ ? 0.f : 1.0f));
    PH(6, ffn_in_phase(F, 1));
    PH(7, out_proj_phase<FF, false, false>(F, ws_bf(F, WS_H), ws_bf(F, WS_FFO + 1 * SZ_FFO), nullptr, nullptr, extra_ ? 0.f : 0.5f));
    PH(8, ffn_in_phase(F, 2));
    PH(9, out_proj_phase<FF, false, false>(F, ws_bf(F, WS_H), ws_bf(F, WS_FFO + 2 * SZ_FFO), nullptr, nullptr, extra_ ? 0.f : 0.5f));
    PH(10, {
        pg8::Gemm g{ws_bf(F, WS_XB), ws_bf(F, WS_AI), MP, 3 * D, D};
        pg8::StaticOrder S; S.init(MP, 3 * D, F.G, (int)blockIdx.x);
        mk::EpiAttnIn E{ws_bf(F, WS_BIG), ws_bf(F, WS_BIG + SZ_ACT), ws_bf(F, WS_BIG + 2 * SZ_ACT), (const float*)(F.ws + WS_RS), F.q_norm, F.k_norm, F.attn_bf,
                        F.out + O_KP, F.out + O_KS, F.out + O_VP, F.out + O_VS, F.out + O_LFP, F.out + O_LFS};
        run_gemm(F, g, S, E);
        __syncthreads();
        small_attn_in(F);
    });
#if MK_FAST_ATTN
    PH(11, { bf16* Oo = extra_ ? ws_bf(F, WS_END) : ws_bf(F, WS_BIG); if (MK_PROBE != 11 || MK_PROBE_REPS < 100 || !extra_) attn_fast_phase(F, lds, Oo); if (MK_PROBE != 11 || MK_PROBE_REPS >= 100 || !extra_) attn_sample_fast(F, Oo); });
#else
    PH(11, attn_simple_phase(F, true));
#endif
    PH(12, out_proj_phase<D, false, false>(F, ws_bf(F, WS_BIG), ws_bf(F, WS_AO), nullptr, nullptr, extra_ ? 0.f : 1.0f));
    PH(13, ffn_in_phase(F, 3));
    PH(14, out_proj_phase<FF, false, true>(F, ws_bf(F, WS_H), ws_bf(F, WS_FFO + 3 * SZ_FFO), nullptr, nullptr, 0.5f));
    if (MK_PROBE == 100) for (int rep_ = 0; rep_ < MK_PROBE_REPS; ++rep_) GRID_BAR();
#undef PH
#undef IN
#undef SEAM
}

extern "C" void kernel_launch(void* const* d_in, const int* in_sizes, int n_in, void* d_out, int out_size, void* d_ws, size_t ws_size, hipStream_t stream) {
    static int grid = 0;
    if (grid == 0) {
        if (n_in != 18 || in_sizes[0] != MP * D || (size_t)out_size != O_END || ws_size < WS_END) {
            fprintf(stderr, "kernel_launch: unexpected problem: n_in %d in0 %d out %d ws %zu; nothing launched\n", n_in, n_in > 0 ? in_sizes[0] : -1, out_size, ws_size); grid = -1; return; }
        int dev = 0, cus = 0, per_cu = 0;
        if (hipGetDevice(&dev) != hipSuccess || hipDeviceGetAttribute(&cus, hipDeviceAttributeMultiprocessorCount, dev) != hipSuccess) { grid = -1; return; }
        if (hipFuncSetAttribute((const void*)mk_fwd, hipFuncAttributeMaxDynamicSharedMemorySize, LDS_BYTES) != hipSuccess) { fprintf(stderr, "kernel_launch: hipFuncSetAttribute failed\n"); grid = -1; return; }
        if (hipOccupancyMaxActiveBlocksPerMultiprocessor(&per_cu, (const void*)mk_fwd, NWAVES * 64, LDS_BYTES) != hipSuccess || per_cu < 1)
            fprintf(stderr, "kernel_launch: note: occupancy query reports %d workgroups per CU\n", per_cu);
        (void)hipGetLastError();
        grid = cus;
    }
    if (grid < 0) return;
    if (hipMemsetAsync((char*)d_ws + WS_CTL, 0, CTL_ZERO_BYTES, stream) != hipSuccess) return;
    Args a{};
    for (int i = 0; i < 18; ++i) a.in[i] = (const float*)d_in[i];
    a.out = (float*)d_out; a.ws = (unsigned char*)d_ws;
#if MK_ONE_LAUNCH
    a.ph_lo = 0; a.ph_hi = NPH;
    hipLaunchKernelGGL(mk_fwd, dim3(grid), dim3(NWAVES * 64), LDS_BYTES, stream, a);
#else
    for (int p = 0; p < NPH; ++p) { a.ph_lo = p; a.ph_hi = p + 1; hipLaunchKernelGGL(mk_fwd, dim3(grid), dim3(NWAVES * 64), LDS_BYTES, stream, a); }
#endif
}
```
